# Optimizing an MI355X kernel written in HIP

```python
import math
import jax
import jax.numpy as jnp
from jax import lax
import numpy as np

D_MODEL = 2048
BATCH = 16
SEQ = 2048
DEPTH = 4

CTX_LEN = 256
GRID_W = 64
N_EVEN = (DEPTH + 1) // 2
N_ODD = DEPTH // 2
D_FF = 4 * D_MODEL
N_MOD = 6
EPS = 1e-6
CONV_W = 3

A_HEAD_DIM = 64
A_WIDTH = D_MODEL // 2
A_HEADS = A_WIDTH // A_HEAD_DIM
A_GROUPS = 2
A_STATE = 128
A_CONV_DIM = A_WIDTH + 2 * A_GROUPS * A_STATE
A_CHUNK = 128

B_WIDTH = D_MODEL // 2
B_HEADS = 8
B_VDIM = B_WIDTH // B_HEADS
B_KDIM = 128
B_FDIM = B_HEADS * B_KDIM
B_CHUNK = 64

C_HEADS = 4
C_V_WIDTH = D_MODEL
C_VDIM = C_V_WIDTH // C_HEADS
C_QKDIM = C_VDIM // 2
C_QK_WIDTH = C_HEADS * C_QKDIM
C_CHUNK = 128

EVEN_SIZES = (A_WIDTH, A_CONV_DIM, 2 * A_HEADS, B_FDIM, 2 * B_FDIM, B_WIDTH, B_WIDTH)
EVEN_IN = sum(EVEN_SIZES)
ODD_SIZES = (2 * C_QK_WIDTH, C_V_WIDTH, C_V_WIDTH, 2 * C_HEADS, 2 * C_HEADS)
ODD_IN = sum(ODD_SIZES)

kernel_name = "bidir_ssd_hgrn2_mlstm_prefix_dit"


def _split(u, sizes):
    return jnp.split(u, [int(s) for s in np.cumsum(sizes)[:-1]], axis=-1)


def rmsnorm(x, w):
    xf = x.astype(jnp.float32)
    y = xf * lax.rsqrt(jnp.mean(xf * xf, axis=-1, keepdims=True) + EPS)
    return (y * w.astype(jnp.float32)).astype(x.dtype)


def group_rmsnorm(y, w, groups):
    shp = y.shape
    yf = y.astype(jnp.float32).reshape(shp[:-1] + (groups, shp[-1] // groups))
    yf = yf * lax.rsqrt(jnp.mean(yf * yf, axis=-1, keepdims=True) + EPS)
    return (yf.reshape(shp) * w.astype(jnp.float32)).astype(y.dtype)


def _dwconv(u, w, b):
    r = CONV_W // 2
    l = u.shape[-2]
    up = jnp.pad(u, [(0, 0)] * (u.ndim - 2) + [(r, r), (0, 0)])
    out = up[..., 0:l, :] * w[0]
    for j in range(1, CONV_W):
        out = out + up[..., j:j + l, :] * w[j]
    return out + b


def short_conv(u_ctx, u_lat, w, b):
    bsz, s, ch = u_lat.shape
    rows = s // GRID_W
    lat = _dwconv(u_lat.reshape(bsz, rows, GRID_W, ch), w, b).reshape(bsz, s, ch)
    return _dwconv(u_ctx, w, b), lat


def _to_chunks(t, n):
    b, l = t.shape[:2]
    return jnp.moveaxis(t.reshape((b, l // n, n) + t.shape[2:]), 1, 0)


def _from_chunks(t):
    nc, b, n = t.shape[:3]
    return jnp.moveaxis(t, 0, 1).reshape((b, nc * n) + t.shape[3:])


def _segsum(a):
    t = a.shape[-1]
    cs = jnp.cumsum(a, axis=-1)
    return jnp.where(jnp.tril(jnp.ones((t, t), dtype=bool)), cs[..., :, None] - cs[..., None, :], -jnp.inf)


def ssd_scan(inputs, h0):
    xdt, a, bm, cm = (t.astype(jnp.float32) for t in inputs)
    bsz, l, h, p = xdt.shape
    g, n = bm.shape[2], bm.shape[3]
    r = h // g
    nc = l // A_CHUNK
    xr = xdt.reshape(bsz, nc, A_CHUNK, g, r, p)
    ar = a.reshape(bsz, nc, A_CHUNK, g, r).transpose(0, 3, 4, 1, 2)
    br = bm.reshape(bsz, nc, A_CHUNK, g, n)
    cr = cm.reshape(bsz, nc, A_CHUNK, g, n)
    a_cs = jnp.cumsum(ar, axis=-1)
    y_diag = jnp.einsum('bclgn,bcsgn,bgrcls,bcsgrp->bclgrp', cr, br, jnp.exp(_segsum(ar)), xr)
    states = jnp.einsum('bclgn,bgrcl,bclgrp->bcgrpn', br, jnp.exp(a_cs[..., -1:] - a_cs), xr)
    states = jnp.concatenate([h0.reshape(bsz, g, r, p, n)[:, None], states], axis=1)
    chunk_a = jnp.pad(a_cs[..., -1], ((0, 0), (0, 0), (0, 0), (1, 0)))
    states = jnp.einsum('bgrzc,bcgrpn->bzgrpn', jnp.exp(_segsum(chunk_a)), states)
    y_off = jnp.einsum('bclgn,bcgrpn,bgrcl->bclgrp', cr, states[:, :-1], jnp.exp(a_cs))
    return (y_diag + y_off).reshape(bsz, l, h, p), states[:, -1].reshape(bsz, h, p, n)


def hgrn2_scan(inputs, s0):
    q, logf, k, v = (t.astype(jnp.float32) for t in inputs)
    mask = jnp.tril(jnp.ones((B_CHUNK, B_CHUNK), dtype=bool))[None, :, :, None, None]

    def step(state, inp):
        qc, gc, kc, vc = inp
        bcum = jnp.cumsum(gc, axis=1)
        rel = jnp.where(mask, bcum[:, :, None] - bcum[:, None, :], -jnp.inf)
        att = jnp.einsum('bthk,btshk,bshk->bhts', qc, jnp.exp(rel), kc)
        o = jnp.einsum('bhts,bshv->bthv', att, vc) + jnp.einsum('bthk,bhkv->bthv', qc * jnp.exp(bcum), state)
        blast = bcum[:, -1]
        state = jnp.exp(blast)[..., None] * state + jnp.einsum('bshk,bshv->bhkv', kc * jnp.exp(blast[:, None] - bcum), vc)
        return state, o

    state, o = lax.scan(step, s0, tuple(_to_chunks(t, B_CHUNK) for t in (q, logf, k, v)))
    return _from_chunks(o), state


def mlstm_scan(inputs, state0):
    q, k, v, logi, logf = (t.astype(jnp.float32) for t in inputs)
    mask = jnp.tril(jnp.ones((C_CHUNK, C_CHUNK), dtype=bool))

    def step(carry, inp):
        cmat, nvec, m = carry
        qc, kc, vc, ic, fc = inp
        bcum = jnp.cumsum(fc, axis=1).transpose(0, 2, 1)
        ih = ic.transpose(0, 2, 1)
        logd = jnp.where(mask, bcum[..., :, None] - bcum[..., None, :] + ih[..., None, :], -jnp.inf)
        gstate = bcum + m[..., None]
        mt = jnp.maximum(jnp.max(logd, axis=-1), gstate)
        w = jnp.einsum('bthd,bshd->bhts', qc, kc) * jnp.exp(logd - mt[..., None])
        sw = jnp.exp(gstate - mt)
        num = jnp.einsum('bhts,bshv->bhtv', w, vc) + sw[..., None] * jnp.einsum('bthd,bhdv->bhtv', qc, cmat)
        den = jnp.sum(w, axis=-1) + sw * jnp.einsum('bthd,bhd->bht', qc, nvec)
        hout = num / jnp.maximum(jnp.abs(den), jnp.exp(-mt))[..., None]
        blast = bcum[..., -1]
        logw = blast[..., None] - bcum + ih
        m_new = jnp.maximum(blast + m, jnp.max(logw, axis=-1))
        ws = jnp.exp(logw - m_new[..., None])
        cs = jnp.exp(blast + m - m_new)
        cmat = cs[..., None, None] * cmat + jnp.einsum('bhs,bshd,bshv->bhdv', ws, kc, vc)
        nvec = cs[..., None] * nvec + jnp.einsum('bhs,bshd->bhd', ws, kc)
        return (cmat, nvec, m_new), hout.transpose(0, 2, 1, 3)

    state, hs = lax.scan(step, state0, tuple(_to_chunks(t, C_CHUNK) for t in (q, k, v, logi, logf)))
    return _from_chunks(hs), state


def _flip_seq(tree):
    return tuple(jnp.flip(t, axis=1) for t in tree)


def bidirectional(scan_fn, ctx_f, ctx_b, lat_f, lat_b, init):
    yc_f, s_f = scan_fn(ctx_f, init)
    yl_f, _ = scan_fn(lat_f, s_f)
    yc_b, s_b = scan_fn(_flip_seq(ctx_b), init)
    yl_b, _ = scan_fn(_flip_seq(lat_b), s_b)
    return yc_f + jnp.flip(yc_b, axis=1), yl_f + jnp.flip(yl_b, axis=1)


def even_mixer(h_c, h_l, w_in, w_out, conv_w, conv_b, a_log, dt_bias, d_skip, ssd_norm_w, lb, hgrn_norm_w, need_ctx):
    bsz = h_l.shape[0]
    z_c, xbc_c, dt_c, q_c, f_c, i_c, g_c = _split(h_c @ w_in, EVEN_SIZES)
    z_l, xbc_l, dt_l, q_l, f_l, i_l, g_l = _split(h_l @ w_in, EVEN_SIZES)

    xbc_c, xbc_l = short_conv(xbc_c, xbc_l, conv_w, conv_b)
    xbc_c, xbc_l = jax.nn.silu(xbc_c), jax.nn.silu(xbc_l)

    def ssd_streams(xbc, dt_raw):
        bs, l, _ = xbc.shape
        xs, bm, cm = _split(xbc, (A_WIDTH, A_GROUPS * A_STATE, A_GROUPS * A_STATE))
        xs = xs.reshape(bs, l, A_HEADS, A_HEAD_DIM)
        bm = bm.reshape(bs, l, A_GROUPS, A_STATE)
        cm = cm.reshape(bs, l, A_GROUPS, A_STATE)
        dirs = []
        for d in range(2):
            dt = jax.nn.softplus(dt_raw[..., d * A_HEADS:(d + 1) * A_HEADS].astype(jnp.float32) + dt_bias[d])
            dirs.append((xs * dt[..., None], -jnp.exp(a_log[d].astype(jnp.float32)) * dt, bm, cm))
        return xs, dirs[0], dirs[1]

    xs_c, sc_f, sc_b = ssd_streams(xbc_c, dt_c)
    xs_l, sl_f, sl_b = ssd_streams(xbc_l, dt_l)
    h0 = jnp.zeros((bsz, A_HEADS, A_HEAD_DIM, A_STATE), jnp.float32)
    ya_c, ya_l = bidirectional(ssd_scan, sc_f, sc_b, sl_f, sl_b, h0)

    def ssd_out(y, xs, z):
        y = y + xs * d_skip[:, None]
        bs, l = y.shape[:2]
        y = y.reshape(bs, l, A_WIDTH).astype(z.dtype)
        return group_rmsnorm(y * jax.nn.silu(z), ssd_norm_w, A_GROUPS)

    log_lb = jnp.log(lb)
    log_1mlb = jnp.log1p(-lb)

    def hgrn_streams(q_raw, f_raw, i_raw):
        bs, l, _ = q_raw.shape
        q = jax.nn.silu(q_raw).reshape(bs, l, B_HEADS, B_KDIM)
        v = i_raw.reshape(bs, l, B_HEADS, B_VDIM)
        dirs = []
        for d in range(2):
            zf = f_raw[..., d * B_FDIM:(d + 1) * B_FDIM].astype(jnp.float32)
            logf = jnp.logaddexp(log_lb, log_1mlb + jax.nn.log_sigmoid(zf))
            kin = (1.0 - lb) * jax.nn.sigmoid(-zf)
            dirs.append((q, logf.reshape(bs, l, B_HEADS, B_KDIM), kin.reshape(bs, l, B_HEADS, B_KDIM), v))
        return dirs[0], dirs[1]

    hc_f, hc_b = hgrn_streams(q_c, f_c, i_c)
    hl_f, hl_b = hgrn_streams(q_l, f_l, i_l)
    s0 = jnp.zeros((bsz, B_HEADS, B_KDIM, B_VDIM), jnp.float32)
    yb_c, yb_l = bidirectional(hgrn2_scan, hc_f, hc_b, hl_f, hl_b, s0)

    def hgrn_out(o, g):
        bs, l = o.shape[:2]
        o = o.reshape(bs, l, B_WIDTH).astype(g.dtype)
        return group_rmsnorm(o, hgrn_norm_w, B_HEADS) * jax.nn.silu(g)

    out_l = jnp.concatenate([ssd_out(ya_l, xs_l, z_l), hgrn_out(yb_l, g_l)], axis=-1) @ w_out
    out_c = None
    if need_ctx:
        out_c = jnp.concatenate([ssd_out(ya_c, xs_c, z_c), hgrn_out(yb_c, g_c)], axis=-1) @ w_out
    return out_c, out_l


def odd_mixer(h_c, h_l, w_in, w_out, conv_w, conv_b, gate_b, norm_w, need_ctx):
    bsz = h_l.shape[0]
    qk_c, v_c, o_c, i_c, f_c = _split(h_c @ w_in, ODD_SIZES)
    qk_l, v_l, o_l, i_l, f_l = _split(h_l @ w_in, ODD_SIZES)
    qk_c, qk_l = short_conv(qk_c, qk_l, conv_w, conv_b)

    def streams(qk, v, i_raw, f_raw):
        bs, l, _ = qk.shape
        q, k = _split(jax.nn.silu(qk), (C_QK_WIDTH, C_QK_WIDTH))
        q = q.reshape(bs, l, C_HEADS, C_QKDIM)
        k = k.reshape(bs, l, C_HEADS, C_QKDIM) * (C_QKDIM ** -0.5)
        v = v.reshape(bs, l, C_HEADS, C_VDIM)
        dirs = []
        for d in range(2):
            logi = i_raw[..., d * C_HEADS:(d + 1) * C_HEADS].astype(jnp.float32) + gate_b[d]
            logf = jax.nn.log_sigmoid(f_raw[..., d * C_HEADS:(d + 1) * C_HEADS].astype(jnp.float32) + gate_b[2 + d])
            dirs.append((q, k, v, logi, logf))
        return dirs[0], dirs[1]

    c_f, c_b = streams(qk_c, v_c, i_c, f_c)
    l_f, l_b = streams(qk_l, v_l, i_l, f_l)
    init = (jnp.zeros((bsz, C_HEADS, C_QKDIM, C_VDIM), jnp.float32),
            jnp.zeros((bsz, C_HEADS, C_QKDIM), jnp.float32),
            jnp.zeros((bsz, C_HEADS), jnp.float32))
    hc, hl = bidirectional(mlstm_scan, c_f, c_b, l_f, l_b, init)

    def readout(hh, o_raw):
        bs, l = hh.shape[:2]
        hh = hh.reshape(bs, l, C_V_WIDTH).astype(o_raw.dtype)
        return (group_rmsnorm(hh, norm_w, C_HEADS) * jax.nn.sigmoid(o_raw)) @ w_out

    out_l = readout(hl, o_l)
    out_c = readout(hc, o_c) if need_ctx else None
    return out_c, out_l


def squared_relu_mlp(h, w1, w2):
    return jnp.square(jax.nn.relu(h @ w1)) @ w2


def setup_inputs(seed: int = 0) -> dict:
    key = jax.random.key(seed)
    ks = iter(jax.random.split(key, 32))

    def nrm(shape, scale):
        return jax.random.normal(next(ks), shape, jnp.float32) * scale

    def unif(shape, lo, hi):
        return jax.random.uniform(next(ks), shape, jnp.float32, minval=lo, maxval=hi)

    dt0 = jnp.exp(unif((N_EVEN, 2, A_HEADS), math.log(1e-3), math.log(1e-1)))
    return {
        "x": nrm((BATCH, SEQ, D_MODEL), 1.0),
        "c": nrm((BATCH, D_MODEL), 1.0),
        "ctx": nrm((BATCH, CTX_LEN, D_MODEL), 1.0),
        "c_ctx": nrm((D_MODEL,), 1.0),
        "mod_w": nrm((DEPTH, D_MODEL, N_MOD * D_MODEL), D_MODEL ** -0.5),
        "mod_b": nrm((DEPTH, N_MOD * D_MODEL), 0.02),
        "norm_w": 1.0 + nrm((DEPTH, 2, D_MODEL), 0.1),
        "final_norm_w": 1.0 + nrm((D_MODEL,), 0.1),
        "mlp_w1": nrm((DEPTH, D_MODEL, D_FF), D_MODEL ** -0.5),
        "mlp_w2": nrm((DEPTH, D_FF, D_MODEL), D_FF ** -0.5),
        "even_w_in": nrm((N_EVEN, D_MODEL, EVEN_IN), D_MODEL ** -0.5),
        "even_w_out": nrm((N_EVEN, A_WIDTH + B_WIDTH, D_MODEL), (A_WIDTH + B_WIDTH) ** -0.5),
        "ssd_conv_w": nrm((N_EVEN, CONV_W, A_CONV_DIM), CONV_W ** -0.5),
        "ssd_conv_b": nrm((N_EVEN, A_CONV_DIM), 0.02),
        "ssd_a_log": jnp.log(unif((N_EVEN, 2, A_HEADS), 1.0, 16.0)),
        "ssd_dt_bias": dt0 + jnp.log(-jnp.expm1(-dt0)),
        "ssd_d": 1.0 + nrm((N_EVEN, A_HEADS), 0.1),
        "ssd_norm_w": 1.0 + nrm((N_EVEN, A_WIDTH), 0.1),
        "hgrn_lb": nrm((N_EVEN, B_FDIM), 0.5),
        "hgrn_norm_w": 1.0 + nrm((N_EVEN, B_WIDTH), 0.1),
        "odd_w_in": nrm((N_ODD, D_MODEL, ODD_IN), D_MODEL ** -0.5),
        "odd_w_out": nrm((N_ODD, C_V_WIDTH, D_MODEL), C_V_WIDTH ** -0.5),
        "mlstm_conv_w": nrm((N_ODD, CONV_W, 2 * C_QK_WIDTH), CONV_W ** -0.5),
        "mlstm_conv_b": nrm((N_ODD, 2 * C_QK_WIDTH), 0.02),
        "mlstm_gate_b": jnp.concatenate([nrm((N_ODD, 2, C_HEADS), 0.1), unif((N_ODD, 2, C_HEADS), 3.0, 6.0)], axis=1),
        "mlstm_norm_w": 1.0 + nrm((N_ODD, C_V_WIDTH), 0.1),
    }


def reference(x, c, ctx, c_ctx, mod_w, mod_b, norm_w, final_norm_w, mlp_w1, mlp_w2,
              even_w_in, even_w_out, ssd_conv_w, ssd_conv_b, ssd_a_log, ssd_dt_bias, ssd_d, ssd_norm_w,
              hgrn_lb, hgrn_norm_w,
              odd_w_in, odd_w_out, mlstm_conv_w, mlstm_conv_b, mlstm_gate_b, mlstm_norm_w):
    lb_all = jnp.cumsum(jax.nn.softmax(hgrn_lb.astype(jnp.float32), axis=0), axis=0)
    lb_all = lb_all - lb_all[0]
    xc = ctx
    for layer in range(DEPTH):
        need_ctx = layer < DEPTH - 1
        mod_l = (jax.nn.silu(c) @ mod_w[layer] + mod_b[layer])[:, None, :]
        mod_c = jax.nn.silu(c_ctx) @ mod_w[layer] + mod_b[layer]
        sh1, sc1, g1, sh2, sc2, g2 = jnp.split(mod_l, N_MOD, axis=-1)
        csh1, csc1, cg1, csh2, csc2, cg2 = jnp.split(mod_c, N_MOD, axis=-1)
        h_l = rmsnorm(x, norm_w[layer, 0]) * (1 + sc1) + sh1
        h_c = rmsnorm(xc, norm_w[layer, 0]) * (1 + csc1) + csh1
        if layer % 2 == 0:
            e = layer // 2
            m_c, m_l = even_mixer(h_c, h_l, even_w_in[e], even_w_out[e], ssd_conv_w[e], ssd_conv_b[e],
                                  ssd_a_log[e], ssd_dt_bias[e], ssd_d[e], ssd_norm_w[e],
                                  lb_all[e], hgrn_norm_w[e], need_ctx)
        else:
            o = layer // 2
            m_c, m_l = odd_mixer(h_c, h_l, odd_w_in[o], odd_w_out[o], mlstm_conv_w[o], mlstm_conv_b[o],
                                 mlstm_gate_b[o], mlstm_norm_w[o], need_ctx)
        x = x + g1 * m_l
        x = x + g2 * squared_relu_mlp(rmsnorm(x, norm_w[layer, 1]) * (1 + sc2) + sh2, mlp_w1[layer], mlp_w2[layer])
        if need_ctx:
            xc = xc + cg1 * m_c
            xc = xc + cg2 * squared_relu_mlp(rmsnorm(xc, norm_w[layer, 1]) * (1 + csc2) + csh2, mlp_w1[layer], mlp_w2[layer])
    return rmsnorm(x, final_norm_w)
```

```cpp
#include <hip/hip_runtime.h>
#include <cstdio>
#include <cstdint>
#ifndef ONE_LAUNCH
#define ONE_LAUNCH 0
#endif
#undef ONE_LAUNCH
#define ONE_LAUNCH 1
__device__ __forceinline__ int opaque_tid(int wv) { unsigned z = 0u; asm volatile("" : "+v"(z)); const int l = (int)__builtin_amdgcn_mbcnt_hi(~0u, __builtin_amdgcn_mbcnt_lo(~0u, z)); return (wv << 6) | l; }
namespace pg8 {
#define PG8_LAS __attribute__((address_space(3)))
typedef unsigned short bf16_t;
typedef short bf16x8 __attribute__((ext_vector_type(8)));
typedef float f32x4 __attribute__((ext_vector_type(4)));
typedef unsigned u32x4 __attribute__((ext_vector_type(4)));
constexpr int BM = 256, BK = 64, HALF = 128, HTB = HALF * BK * 2  , STAGE_BYTES = 8 * HTB, NXCD = 8, WGM = 8;

__host__ __device__ __forceinline__ int lds_byte(int r, int c) { const int st = (r >> 4) * 2 + (c >> 5), rr = r & 15, cc = c & 31, ob = rr * 64 + cc * 2; return st * 1024 + (ob ^ (((ob >> 9) & 1) << 5)); }
__host__ __device__ __forceinline__ void stage_rc(int b, int& R, int& C) { const int st = b / 1024, sb = b % 1024, swz = sb ^ (((sb >> 9) & 1) << 5); R = (st >> 1) * 16 + swz / 64; C = (st & 1) * 32 + (swz % 64) / 2; }
__host__ __device__ __forceinline__ int perm32(int rho) { const int n = rho >> 4, i = rho & 15; return 8 * (i >> 2) + 4 * n + (i & 3); }

__host__ __device__ __forceinline__ int perm32_inv(int cidx) { return ((cidx >> 2) & 1) * 16 + ((cidx >> 3) << 2) + (cidx & 3); }
__host__ __device__ __forceinline__ size_t tiled_off(size_t row, int col, int K, bool perm = false) {
    int r = (int)(row & 127); if (perm) r = (r & ~31) + perm32_inv(r & 31);
    return ((row >> 8) * (size_t)(K / BK) + (size_t)(col >> 6)) * (size_t)(BM * BK) + ((row >> 7) & 1) * (size_t)(HALF * BK) + (size_t)(lds_byte(r, col & 63) >> 1);
}
struct Unit { int pm, pn, kt0, nkt, part; };
struct Gemm { const bf16_t* A; const bf16_t* Bt; int M, N, K; };

struct StaticOrder {
    int nM, nN, nwg, G, c, nkt, wgm;
    __host__ __device__ void init(int M, int N, int K, int G_, int c_, int wgm_ = WGM) { nM = M / BM; nN = N / BM; nwg = nM * nN; G = G_; c = c_; nkt = K / BK; wgm = wgm_; }
    __host__ __device__ bool next(int i, Unit& u) const {
        const long L = (long)i * G + c; if (L >= nwg) return false;
        u.kt0 = 0; u.nkt = nkt; u.part = 0;
        int wgid = (int)L; { const int q = nwg / NXCD, r = nwg % NXCD, xcd = wgid % NXCD, off = wgid / NXCD; wgid = (xcd < r ? xcd * (q + 1) : r * (q + 1) + (xcd - r) * q) + off; }
        const int nig = wgm * nN, gid = wgid / nig, fm = gid * wgm, gsz = (nM - fm) < wgm ? (nM - fm) : wgm;
        u.pm = fm + ((wgid % nig) % gsz); u.pn = (wgid % nig) / gsz; return true;
    }
    __device__ __forceinline__ void a_ready(const Unit&) const {}
    __device__ __forceinline__ void done(const Unit&) const {}
};

struct ResOrder {
    StaticOrder lat; int ctx, nkt, c, G;
    __host__ __device__ void init(int N, int K, int G_, int c_, int with_ctx, int wgm_ = WGM) { lat.init(32768, N, K, G_, c_, wgm_); ctx = with_ctx; nkt = K / BK; c = c_; G = G_; }
    __host__ __device__ bool next(int i, Unit& u) const {
        if (lat.next(i, u)) { u.pm += 16; return true; }
        if (!ctx) return false;
        const int r0 = (lat.nwg + G - 1) / G;
        if (G == 256) {
            if (i != r0) return false;
            const int j = c & 127; u.pm = j & 15; u.pn = j >> 4; u.part = 1 + (c >> 7); u.nkt = nkt / 2; u.kt0 = (c >> 7) * (nkt / 2); return true;
        }
        const long j = (long)(i - r0) * G + c; if (i < r0 || j >= 128) return false;
        u.pm = (int)(j & 15); u.pn = (int)(j >> 4); u.part = 0; u.nkt = nkt; u.kt0 = 0; return true;
    }
    __device__ __forceinline__ void a_ready(const Unit&) const {}
    __device__ __forceinline__ void done(const Unit&) const {}
};

struct InOrder {
    StaticOrder lat; int nN, G, c, nkt, skip_lo, skip_n;
    __host__ __device__ void init(int N, int K, int G_, int c_, int wgm_, int skip_lo_, int skip_hi_) { lat.init(32768, N, K, G_, c_, wgm_); nN = N / BM; G = G_; c = c_; nkt = K / BK; skip_lo = skip_lo_; skip_n = skip_hi_ - skip_lo_; }
    __host__ __device__ bool next(int i, Unit& u) const {
        if (lat.next(i, u)) { u.pm += 16; return true; }
        const long j = (long)i * G + c - lat.nwg; if (j < 0 || j >= 16L * (nN - skip_n)) return false;
        const int q = (int)(j >> 4); u.pm = (int)(j & 15); u.pn = q < skip_lo ? q : q + skip_n; u.kt0 = 0; u.nkt = nkt; u.part = 0; return true;
    }
    __device__ __forceinline__ void a_ready(const Unit&) const {}
    __device__ __forceinline__ void done(const Unit&) const {}
};

typedef __bf16 nbf16x2 __attribute__((ext_vector_type(2))); typedef float nf32x2 __attribute__((ext_vector_type(2)));
__device__ __forceinline__ unsigned cvt_pk_bf16(float lo, float hi) { const nf32x2 f = {lo, hi}; return __builtin_bit_cast(unsigned, __builtin_convertvector(f, nbf16x2)); }
typedef float f32x2 __attribute__((ext_vector_type(2)));
template <class Epi, class Sched, bool ALIGN_EPI = false, bool SP2 = false>
__device__ __forceinline__ void gemm_phase(int wv, PG8_LAS unsigned char* lds, const Gemm g, const Sched& S, const Epi& E) {
    const int tid = opaque_tid(wv), wid = __builtin_amdgcn_readfirstlane(tid >> 6), lane = tid & 63, wr = wid >> 2, wc = wid & 3, fr = lane & 15, fq = lane >> 4;
    const int K = g.K;
    unsigned voffA[2], voffB[2];
#pragma unroll
    for (int i = 0; i < 2; ++i) { voffA[i] = (unsigned)(tid * 16 + i * 8192); voffB[i] = voffA[i]; }
    const size_t kstep = (size_t)(BM * BK * 2);
    const size_t hstep = (size_t)HALF * BK * 2;
    const size_t tstep = (size_t)(K / BK) * kstep;
    const unsigned ldsw = (unsigned)wid * 1024u;
    const int aoff = lds_byte(wr * 64 + fr, fq * 8), boff = lds_byte(wc * 32 + fr, fq * 8);
#define PG8_SA(b, h) (((b) * 2 + (h)) * HTB)
#define PG8_SB(b, h) ((4 + (b) * 2 + (h)) * HTB)
#define PG8_STAGE(bufoff, gbase, voff) do { _Pragma("unroll") for (int _i = 0; _i < 2; ++_i) \
        __builtin_amdgcn_global_load_lds((const unsigned*)((const char*)(gbase) + (voff)[_i]), (PG8_LAS unsigned*)(lds + (bufoff) + ldsw + _i * 8192), 16, 0, 0); } while (0)
#define PG8_LDA(dst, b, h) do { _Pragma("unroll") for (int m = 0; m < 4; ++m) _Pragma("unroll") for (int k = 0; k < 2; ++k) dst[m][k] = *(const PG8_LAS bf16x8*)(lds + PG8_SA(b, h) + aoff + m * 2048 + k * 1024); } while (0)
#define PG8_LDB(dst, b, h) do { _Pragma("unroll") for (int n = 0; n < 2; ++n) _Pragma("unroll") for (int k = 0; k < 2; ++k) dst[n][k] = *(const PG8_LAS bf16x8*)(lds + PG8_SB(b, h) + boff + n * 2048 + k * 1024); } while (0)
#define PG8_MMA(ai, bj, At, Bt) do { __builtin_amdgcn_s_setprio(1); _Pragma("unroll") for (int m = 0; m < 4; ++m) _Pragma("unroll") for (int n = 0; n < 2; ++n) _Pragma("unroll") for (int k = 0; k < 2; ++k) \
        acc[ai][bj][m][n] = __builtin_amdgcn_mfma_f32_16x16x32_bf16(Bt[n][k], At[m][k], acc[ai][bj][m][n], 0, 0, 0); __builtin_amdgcn_s_setprio(0); } while (0)
#define PG8_WAIT_V(n) asm volatile("s_waitcnt vmcnt(" #n ")" ::: "memory")
#define PG8_WAIT_L(n) asm volatile("s_waitcnt lgkmcnt(" #n ")" ::: "memory")
#define PG8_BAR __builtin_amdgcn_s_barrier()
#define PG8_SCHED __builtin_amdgcn_sched_barrier(0)
    Unit cur, nxt; int ui = 0;
    if (!S.next(0, cur)) return;
    f32x4 acc[2][2][4][2];
#pragma unroll
    for (int a = 0; a < 2; ++a)
#pragma unroll
        for (int b = 0; b < 2; ++b)
#pragma unroll
            for (int m = 0; m < 4; ++m)
#pragma unroll
                for (int n = 0; n < 2; ++n) acc[a][b][m][n] = (f32x4){0.f, 0.f, 0.f, 0.f};
    bf16x8 At[4][2], B0[2][2], B1[2][2];
    const char* cA = (const char*)g.A + (size_t)cur.pm * tstep + (size_t)cur.kt0 * kstep; const char* cB = (const char*)g.Bt + (size_t)cur.pn * tstep + (size_t)cur.kt0 * kstep;
    S.a_ready(cur);
    if constexpr (SP2) {
        PG8_STAGE(PG8_SB(0, 0), cB, voffB); PG8_STAGE(PG8_SB(0, 1), cB + hstep, voffB); PG8_STAGE(PG8_SA(0, 0), cA, voffA); PG8_STAGE(PG8_SA(0, 1), cA + hstep, voffA);
        if (wr == 1) PG8_BAR;
        PG8_WAIT_V(2); PG8_BAR;
        PG8_STAGE(PG8_SB(1, 0), cB + kstep, voffB); PG8_STAGE(PG8_SA(1, 0), cA + kstep, voffA); PG8_STAGE(PG8_SB(1, 1), cB + hstep + kstep, voffB);
        PG8_WAIT_V(6); PG8_BAR;
    } else {
        PG8_STAGE(PG8_SB(0, 0), cB, voffB); PG8_STAGE(PG8_SA(0, 0), cA, voffA); PG8_STAGE(PG8_SB(0, 1), cB + hstep, voffB); PG8_STAGE(PG8_SA(0, 1), cA + hstep, voffA);
        if (wr == 1) PG8_BAR;
        PG8_WAIT_V(4); PG8_BAR;
        PG8_STAGE(PG8_SB(1, 0), cB + kstep, voffB); PG8_STAGE(PG8_SA(1, 0), cA + kstep, voffA); PG8_STAGE(PG8_SB(1, 1), cB + hstep + kstep, voffB);
        PG8_WAIT_V(6); PG8_BAR;
    }
    for (;;) {
        const bool has_next = S.next(ui + 1, nxt);
        const char* nA = has_next ? (const char*)g.A + (size_t)nxt.pm * tstep + (size_t)nxt.kt0 * kstep : cA; const char* nB = has_next ? (const char*)g.Bt + (size_t)nxt.pn * tstep + (size_t)nxt.kt0 * kstep : cB;
        const int nt = cur.nkt;
        for (int t = 0; t < nt; t += 2) {
            const bool last = (t == nt - 2);
            const char* a1 = cA + (size_t)(t + 1) * kstep;
            const char* a2 = last ? nA : cA + (size_t)(t + 2) * kstep; const char* b2 = last ? nB : cB + (size_t)(t + 2) * kstep;
            const char* a3 = a2 + kstep; const char* b3 = b2 + kstep;
            if (last && has_next) S.a_ready(nxt);
            if constexpr (SP2) {
            PG8_LDB(B0, 0, 0); PG8_LDB(B1, 0, 1); PG8_SCHED; PG8_LDA(At, 0, 0); PG8_STAGE(PG8_SA(1, 1), a1 + hstep, voffA);
            PG8_WAIT_V(8); PG8_WAIT_L(0); PG8_BAR; PG8_MMA(0, 0, At, B0); PG8_MMA(0, 1, At, B1); PG8_BAR; PG8_SCHED;
            PG8_LDA(At, 0, 1); PG8_STAGE(PG8_SB(0, 0), b2, voffB); PG8_STAGE(PG8_SB(0, 1), b2 + hstep, voffB); PG8_STAGE(PG8_SA(0, 0), a2, voffA);
            PG8_WAIT_V(8); PG8_WAIT_L(0); PG8_BAR; PG8_MMA(1, 0, At, B0); PG8_MMA(1, 1, At, B1); PG8_BAR; PG8_SCHED;
            PG8_LDB(B0, 1, 0); PG8_LDB(B1, 1, 1); PG8_SCHED; PG8_LDA(At, 1, 0); PG8_STAGE(PG8_SA(0, 1), a2 + hstep, voffA);
            PG8_WAIT_V(8); PG8_WAIT_L(0); PG8_BAR; PG8_MMA(0, 0, At, B0); PG8_MMA(0, 1, At, B1); PG8_BAR; PG8_SCHED;
            PG8_LDA(At, 1, 1); PG8_STAGE(PG8_SB(1, 0), b3, voffB); PG8_STAGE(PG8_SB(1, 1), b3 + hstep, voffB); PG8_STAGE(PG8_SA(1, 0), a3, voffA);
            PG8_WAIT_V(8); PG8_WAIT_L(0); PG8_BAR; PG8_MMA(1, 0, At, B0); PG8_MMA(1, 1, At, B1); PG8_BAR; PG8_SCHED;
            } else {
            PG8_LDB(B0, 0, 0); PG8_SCHED; PG8_LDA(At, 0, 0); PG8_STAGE(PG8_SA(1, 1), a1 + hstep, voffA);
            PG8_WAIT_L(8); PG8_BAR; PG8_WAIT_L(0); PG8_MMA(0, 0, At, B0); PG8_BAR; PG8_SCHED;
            PG8_LDB(B1, 0, 1); PG8_STAGE(PG8_SB(0, 0), b2, voffB);
            PG8_BAR; PG8_WAIT_L(0); PG8_MMA(0, 1, At, B1); PG8_BAR;
            PG8_LDA(At, 0, 1); PG8_STAGE(PG8_SA(0, 0), a2, voffA);
            PG8_BAR; PG8_WAIT_L(0); PG8_MMA(1, 0, At, B0); PG8_BAR; PG8_SCHED;
            PG8_STAGE(PG8_SB(0, 1), b2 + hstep, voffB);
            PG8_WAIT_V(6); PG8_BAR; PG8_MMA(1, 1, At, B1); PG8_BAR;
            PG8_LDB(B0, 1, 0); PG8_SCHED; PG8_LDA(At, 1, 0); PG8_STAGE(PG8_SA(0, 1), a2 + hstep, voffA);
            PG8_WAIT_L(8); PG8_BAR; PG8_WAIT_L(0); PG8_MMA(0, 0, At, B0); PG8_BAR; PG8_SCHED;
            PG8_LDB(B1, 1, 1); PG8_STAGE(PG8_SB(1, 0), b3, voffB);
            PG8_BAR; PG8_WAIT_L(0); PG8_MMA(0, 1, At, B1); PG8_BAR;
            PG8_LDA(At, 1, 1); PG8_STAGE(PG8_SA(1, 0), a3, voffA);
            PG8_BAR; PG8_WAIT_L(0); PG8_MMA(1, 0, At, B0); PG8_BAR; PG8_SCHED;
            PG8_STAGE(PG8_SB(1, 1), b3 + hstep, voffB);
            PG8_WAIT_V(6); PG8_BAR; PG8_MMA(1, 1, At, B1); PG8_BAR;
            }
        }
        if constexpr (ALIGN_EPI) { if (wr == 0) PG8_BAR; }
        if constexpr (!Epi::AFTER_DRAIN) { E(acc, cur, wr, wc, fr, fq); S.done(cur); }
        if (!has_next) break;
#pragma unroll
        for (int a = 0; a < 2; ++a)
#pragma unroll
            for (int b = 0; b < 2; ++b)
#pragma unroll
                for (int m = 0; m < 4; ++m)
#pragma unroll
                    for (int n = 0; n < 2; ++n) acc[a][b][m][n] = (f32x4){0.f, 0.f, 0.f, 0.f};
        cur = nxt; cA = nA; cB = nB; ++ui;
        if constexpr (ALIGN_EPI) { if (wr == 1) PG8_BAR; }
    }
    PG8_WAIT_V(0);
    if constexpr (!ALIGN_EPI) { if (wr == 0) PG8_BAR; }
    PG8_BAR;
    if constexpr (Epi::AFTER_DRAIN) { E.fused(acc, cur, wr, wc, fr, fq, lds, wid, lane); S.done(cur); }
#undef PG8_SA
#undef PG8_SB
#undef PG8_STAGE
#undef PG8_LDA
#undef PG8_LDB
#undef PG8_MMA
#undef PG8_WAIT_V
#undef PG8_WAIT_L
#undef PG8_BAR
#undef PG8_SCHED
}
}

#define XB_TMO      128
#define XB_XCNT(j)  (256  + 64 * (j))
#define XB_XSUB(j)  (1280 + 64 * (j))
#define XB_XGEN(j)  (2304 + 64 * (j))
#define XB_TOP      3328
#define XB_TOPGEN   3392
#define XCD_BAR_WORDS 3456
#define XB_SPIN_CAP (1u << 18)
#define LAS __attribute__((address_space(3)))

__device__ __forceinline__ unsigned xb_ld(unsigned* p)              { return __hip_atomic_load(p, __ATOMIC_RELAXED, __HIP_MEMORY_SCOPE_AGENT); }
__device__ __forceinline__ unsigned xb_add(unsigned* p, unsigned v) { return __hip_atomic_fetch_add(p, v, __ATOMIC_RELAXED, __HIP_MEMORY_SCOPE_AGENT); }
__device__ __forceinline__ unsigned xb_xcc_id() { return (unsigned)__builtin_amdgcn_s_getreg((3 << 11) | 20) & 0xFu; }
#define XB_SPIN(cond, bar) do { unsigned _sp = 0; while (cond) { __builtin_amdgcn_s_sleep(1); \
    if ((++_sp & 255u) == 0u) { if (xb_ld(&(bar)[XB_TMO])) break; if (_sp > XB_SPIN_CAP) { atomicAdd(&(bar)[XB_TMO], 1u); break; } } } } while (0)

struct XcdBarrier {
    unsigned* bar; unsigned x; int wv;
    volatile LAS unsigned* st;
};

__device__ __forceinline__ XcdBarrier xcd_barrier_post(unsigned* bar, volatile LAS unsigned* st, int wv) {
    XcdBarrier b; b.bar = bar; b.x = xb_xcc_id(); b.st = st; b.wv = wv;
    if (opaque_tid(wv) == 0) (void)xb_add(&bar[XB_XCNT(b.x)], 1u);
    return b;
}
__device__ __forceinline__ void xcd_barrier_complete(unsigned* bar, unsigned x, unsigned& nloc, unsigned& nx) {
    const unsigned G = gridDim.x * gridDim.y * gridDim.z;
    unsigned sum, cnt, mine, sp = 0u;
    for (;;) {
        sum = 0u; cnt = 0u; mine = 0u;
#pragma unroll
        for (unsigned j = 0; j < 16; ++j) { const unsigned c = xb_ld(&bar[XB_XCNT(j)]); sum += c; cnt += (c > 0u) ? 1u : 0u; mine = (j == x) ? c : mine; }
        if (sum == G) break;
        __builtin_amdgcn_s_sleep(1);
        if ((++sp & 255u) == 0u) { if (xb_ld(&bar[XB_TMO])) break; if (sp > XB_SPIN_CAP) { atomicAdd(&bar[XB_TMO], 1u); break; } }
    }
    nloc = mine > 0u ? mine : 1u; nx = cnt > 0u ? cnt : 1u;
}

__device__ __forceinline__ void xcd_barrier(const XcdBarrier& b) {
    asm volatile("s_waitcnt vmcnt(0)" ::: "memory");
    __syncthreads();
    if (opaque_tid(b.wv) == 0) {
        unsigned* bar = b.bar;
        __builtin_amdgcn_s_waitcnt(0);
        unsigned nloc = b.st[0], nx = b.st[1];
        if (nloc == 0u) { xcd_barrier_complete(bar, b.x, nloc, nx); b.st[0] = nloc; b.st[1] = nx; }
        const unsigned old = xb_add(&bar[XB_XSUB(b.x)], 1u);
        const unsigned gen = old / nloc;
        if (old + 1u == (gen + 1u) * nloc) {
            __builtin_amdgcn_fence(__ATOMIC_RELEASE, "agent");
            asm volatile("s_waitcnt vmcnt(0)" ::: "memory");
            const unsigned og = xb_add(&bar[XB_TOP], 1u);
            const unsigned tg = og / nx;
            if (og + 1u == (tg + 1u) * nx) xb_add(&bar[XB_TOPGEN], 1u);
            else XB_SPIN(xb_ld(&bar[XB_TOPGEN]) == tg, bar);
            __builtin_amdgcn_fence(__ATOMIC_ACQUIRE, "agent");
            xb_add(&bar[XB_XGEN(b.x)], 1u);
            asm volatile("s_waitcnt vmcnt(0)" ::: "memory");
        } else {
            XB_SPIN(xb_ld(&bar[XB_XGEN(b.x)]) == gen, bar);
            __builtin_amdgcn_fence(__ATOMIC_ACQUIRE, "agent");
            asm volatile("s_waitcnt vmcnt(0)" ::: "memory");
        }
    }
    __syncthreads();
}


#define LASP __attribute__((address_space(3)))
typedef unsigned short bf16;
typedef pg8::f32x4 f32x4;
typedef pg8::u32x4 u32x4;
typedef unsigned u32x2 __attribute__((ext_vector_type(2)));
typedef float f32x2 __attribute__((ext_vector_type(2)));
constexpr int D = 2048, BATCH = 16, SEQ = 2048, CTX = 256, DEPTH = 4, DFF = 8192;
constexpr int TC = BATCH * CTX, TL = BATCH * SEQ, T = TC + TL;
constexpr int MODW = 6 * D;
constexpr int EVEN_IN = 7712, ODD_IN = 6160;
constexpr int EV_MAIN = 7680, EV_PAD = 7936, OD_MAIN = 6144, OD_PAD = 6400;
constexpr int EU_Z = 0, EU_XBC = 1024, EU_Q = 2560, EU_F = 3584, EU_I = 5632, EU_G = 6656;
constexpr int OU_QK = 0, OU_V = 2048, OU_O = 4096;
constexpr float EPS = 1e-6f;

constexpr size_t MiB = 1u << 20;
constexpr size_t WS_CTL = 0, CTL_BYTES = 64 * 1024;
constexpr size_t WS_MOD = 1 * MiB;
constexpr size_t WS_GATES = 5 * MiB;
constexpr size_t WS_XC = 10 * MiB;
constexpr size_t WS_XL = 42 * MiB;
constexpr size_t WS_WT = 170 * MiB;
constexpr size_t WT_IN_E = (size_t)EV_PAD * D * 2, WT_IN_O = (size_t)OD_PAD * D * 2, WT_OUT = (size_t)D * D * 2, WT_W1 = (size_t)DFF * D * 2, WT_W2 = (size_t)D * DFF * 2;
constexpr size_t WT_LAYER = 104 * MiB;
constexpr size_t WS_H = WS_WT + WT_LAYER;
constexpr size_t WS_U = WS_H + (size_t)T * D * 2;
constexpr size_t WS_SO = WS_U + (size_t)T * DFF * 2;
constexpr size_t WS_END = WS_SO + (size_t)T * D * 4;
static_assert(WT_IN_E + WT_OUT + WT_W1 + WT_W2 <= WT_LAYER, "weights per layer");
static_assert(WS_END <= (size_t)1536 * MiB && WS_XL + (size_t)TL * D * 2 <= WS_WT, "workspace");
constexpr int CW_BAR = 4096;

constexpr int LDS_BYTES = 147456;
constexpr int LDS_BARW = LDS_BYTES - 64;

struct Params { const float* in[26]; float* out; unsigned char* ws; int ph_lo, ph_hi; };
enum { I_X = 0, I_C, I_CTX, I_CCTX, I_MODW, I_MODB, I_NORMW, I_FNORMW, I_W1, I_W2, I_EWIN, I_EWOUT, I_SCONVW, I_SCONVB, I_ALOG, I_DTB, I_SSDD, I_SSDNW, I_HLB, I_HNW, I_OWIN, I_OWOUT, I_MCONVW, I_MCONVB, I_MGATEB, I_MNW };

__device__ __forceinline__ const float* pin(const Params& p, int i) { asm volatile("" : "+s"(i)); return p.in[i]; }
__device__ __forceinline__ float bf2f(bf16 h) { return __uint_as_float((unsigned)h << 16); }
__device__ __forceinline__ float bf_lo(unsigned w) { return __uint_as_float(w << 16); }
__device__ __forceinline__ float bf_hi(unsigned w) { return __uint_as_float(w & 0xffff0000u); }
__device__ __forceinline__ void unpack8(const u32x4 w, float (&f)[8]) { f[0] = bf_lo(w.x); f[1] = bf_hi(w.x); f[2] = bf_lo(w.y); f[3] = bf_hi(w.y); f[4] = bf_lo(w.z); f[5] = bf_hi(w.z); f[6] = bf_lo(w.w); f[7] = bf_hi(w.w); }
__device__ __forceinline__ u32x4 pack8(const float (&f)[8]) { u32x4 w; w.x = pg8::cvt_pk_bf16(f[0], f[1]); w.y = pg8::cvt_pk_bf16(f[2], f[3]); w.z = pg8::cvt_pk_bf16(f[4], f[5]); w.w = pg8::cvt_pk_bf16(f[6], f[7]); return w; }
__device__ __forceinline__ float sigmoid_(float x) { return 1.f / (1.f + __expf(-x)); }
__device__ __forceinline__ float silu_(float x) { return x / (1.f + __expf(-x)); }
__device__ __forceinline__ float log1p_pos(float y) { return y < 0.0078125f ? y * (1.f - y * (0.5f - y * 0.33333334f)) : __logf(1.f + y); }
__device__ __forceinline__ float softplus_(float x) { return x > 20.f ? x : log1p_pos(__expf(x)); }
__device__ __forceinline__ float shx(float v, int m, int lane) { return __int_as_float(__builtin_amdgcn_ds_bpermute((lane ^ m) << 2, __float_as_int(v))); }
__device__ __forceinline__ float shup(float v, int o, int lane) { return __int_as_float(__builtin_amdgcn_ds_bpermute((lane - o) << 2, __float_as_int(v))); }
__device__ __forceinline__ float rdlane(float v, int l) { return __int_as_float(__builtin_amdgcn_readlane(__float_as_int(v), l)); }
__device__ __forceinline__ float wave_sum(float v, int lane) {
#pragma unroll
    for (int o = 32; o > 0; o >>= 1) v += shx(v, o, lane);
    return v;
}
__device__ __forceinline__ int seq_row(int b, int dir, int s) {
    if (s < CTX) return b * CTX + (dir ? (CTX - 1 - s) : s);
    const int j = s - CTX; return TC + b * SEQ + (dir ? (SEQ - 1 - j) : j);
}

__device__ __forceinline__ int chunk_row0(int b, int dir, int c) {
    if (c < CTX / 64) return b * CTX + (dir ? CTX - 64 - c * 64 : c * 64);
    const int j0 = (c - CTX / 64) * 64; return TC + b * SEQ + (dir ? SEQ - 64 - j0 : j0);
}
__device__ __forceinline__ int rix(int dir, int s) { return dir ? 63 - s : s; }

__device__ __forceinline__ int wt_map(int n, int mode, int Nsrc) {
    if (mode == 0) return n < Nsrc ? n : -1;
    if (n < 2560) return n;
    if (n < EV_MAIN) return n + 32;
    if (n < EV_MAIN + 32) return 2560 + (n - EV_MAIN);
    return -1;
}
__device__ __forceinline__ void convert_wt(int wv, const float* src, int K, int ldsrc, int Nsrc, bf16* dst, int Npad, int mode, LASP float* tile) {
    const int tid = opaque_tid(wv), nkt = K / 64, nnt = Npad / 64, ntiles = nkt * nnt;
    for (int it0 = blockIdx.x; it0 < ntiles; it0 += 4 * gridDim.x) {
        f32x4 v[4][2];
#pragma unroll
        for (int q = 0; q < 4; ++q) { const int it = it0 + q * gridDim.x; const bool live = it < ntiles; const int itc = live ? it : it0;
            const int ntl = itc % nnt, kt = itc / nnt, k0 = kt * 64, n0 = ntl * 64;
#pragma unroll
            for (int i = 0; i < 2; ++i) { const int e = tid + i * 512, kk = e >> 4, n4 = (e & 15) * 4, sc = wt_map(n0 + n4, mode, Nsrc);
                v[q][i] = (f32x4){0.f, 0.f, 0.f, 0.f};
                if (sc >= 0) v[q][i] = *(const f32x4*)(src + (size_t)(k0 + kk) * ldsrc + sc); } }
#pragma unroll
        for (int q = 0; q < 4; ++q) { LASP float* tl = tile + q * (64 * 65);
#pragma unroll
            for (int i = 0; i < 2; ++i) { const int e = tid + i * 512, kk = e >> 4, n4 = (e & 15) * 4;
                tl[kk * 65 + n4 + 0] = v[q][i][0]; tl[kk * 65 + n4 + 1] = v[q][i][1]; tl[kk * 65 + n4 + 2] = v[q][i][2]; tl[kk * 65 + n4 + 3] = v[q][i][3]; } }
        __syncthreads();
#pragma unroll
        for (int q = 0; q < 4; ++q) { const int it = it0 + q * gridDim.x; if (it >= ntiles) break;
            const int ntl = it % nnt, kt = it / nnt, k0 = kt * 64, n0 = ntl * 64; LASP float* tl = tile + q * (64 * 65);
            const int n = tid >> 3, k8 = (tid & 7) * 8; float f[8];
#pragma unroll
            for (int j = 0; j < 8; ++j) f[j] = tl[(k8 + j) * 65 + n];
            *(u32x4*)(dst + pg8::tiled_off((size_t)(n0 + n), k0 + k8, K, true)) = pack8(f); }
        __syncthreads();
    }
}

__device__ __forceinline__ void phase_mod(int wv, const Params& p, LASP unsigned char* lds) {
    const int tid = opaque_tid(wv), lane = tid & 63, wave = wv;
    LASP float* s = (LASP float*)lds;
    LASP float* red = (LASP float*)(lds + 17 * 2048 * 4);
    const float* c = pin(p, I_C); const float* cc = pin(p, I_CCTX);
    for (int i = tid; i < 17 * 2048; i += 512) { const float v = i < 16 * 2048 ? c[i] : cc[i - 16 * 2048]; s[i] = silu_(v); }
    __syncthreads();
    const float* mw = pin(p, I_MODW); const float* mb = pin(p, I_MODB); float* mod = (float*)(p.ws + WS_MOD);
    for (int unit = blockIdx.x; unit < 4 * 192; unit += gridDim.x) {
        const int l = unit / 192, cg = unit % 192, col = cg * 64 + lane;
        for (int i = tid; i < 17 * 64; i += 512) red[i] = 0.f;
        __syncthreads();
        float acc[17];
#pragma unroll
        for (int r = 0; r < 17; ++r) acc[r] = 0.f;
        const float* wp = mw + ((size_t)l * 2048 + wave * 256) * MODW + col;
#pragma unroll 2
        for (int k = 0; k < 256; k += 4) {
            const float w0 = wp[(size_t)(k + 0) * MODW], w1 = wp[(size_t)(k + 1) * MODW], w2 = wp[(size_t)(k + 2) * MODW], w3 = wp[(size_t)(k + 3) * MODW];
#pragma unroll
            for (int r = 0; r < 17; ++r) { const f32x4 sv = *(const LASP f32x4*)(s + r * 2048 + wave * 256 + k); acc[r] += sv[0] * w0 + sv[1] * w1 + sv[2] * w2 + sv[3] * w3; }
        }
        for (int w = 0; w < 8; ++w) {
            if (wave == w) {
#pragma unroll
                for (int r = 0; r < 17; ++r) red[r * 64 + lane] += acc[r];
            }
            __syncthreads();
        }
        for (int i = tid; i < 17 * 64; i += 512) { const int r = i >> 6, cl = i & 63; mod[((size_t)l * 17 + r) * MODW + cg * 64 + cl] = red[i] + mb[(size_t)l * MODW + cg * 64 + cl]; }
        __syncthreads();
    }
}

__device__ __forceinline__ void load_x8(const void* base, bool is_f32, size_t eoff, float (&v)[8]) {
    if (is_f32) { const f32x4 a = *(const f32x4*)((const float*)base + eoff), b = *(const f32x4*)((const float*)base + eoff + 4);
        v[0] = a[0]; v[1] = a[1]; v[2] = a[2]; v[3] = a[3]; v[4] = b[0]; v[5] = b[1]; v[6] = b[2]; v[7] = b[3]; }
    else unpack8(*(const u32x4*)((const bf16*)base + eoff), v);
}
__device__ __forceinline__ void norm_load_pair(const void* xc_src, const void* xl_src, bool src_f32, int row, int lane, float (&va)[4][8], float (&vb)[4][8]) {
    const void* base = row < TC ? xc_src : xl_src; const int rr = row < TC ? row : row - TC;
#pragma unroll
    for (int j = 0; j < 4; ++j) { const int k = j * 512 + lane * 8;
        load_x8(base, src_f32, (size_t)rr * D + k, va[j]); load_x8(base, src_f32, (size_t)(rr + 1) * D + k, vb[j]); }
}
__device__ __forceinline__ void phase_norm(int wv, const void* xc_src, const void* xl_src, bool src_f32, const float* nw, const float* modl, int isc, int ish, bf16* h, int row_lo, const float* pb, bf16* xc_wb, LASP unsigned char* lds) {
    const int tid = opaque_tid(wv), lane = tid & 63;
    LASP float* cs = (LASP float*)lds;
    LASP float* ss = cs + 2048;
    int vp0 = blockIdx.x; asm volatile("" : "+s"(vp0));
#pragma unroll 1
    for (int vp = vp0; vp < 512; vp += gridDim.x) {
        const int part = vp >> 8, vb = vp & 255;
        const int lo = part == 0 ? row_lo : (row_lo > TC ? row_lo : TC), hi = part == 0 ? TC : T;
        if (lo >= hi) continue;
        const int per = (((hi - lo) / 2 + 255) >> 8) * 2;
        int r0 = lo + vb * per; const int r1 = r0 + per < hi ? r0 + per : hi;
        while (r0 < r1) {
            const int mr = r0 < TC ? 16 : (r0 - TC) / SEQ;
            const int seg_end = r0 < TC ? TC : TC + (mr + 1) * SEQ;
            const int re = r1 < seg_end ? r1 : seg_end;
            __syncthreads();
            { const int k = tid * 4; const float* sc = modl + (size_t)mr * MODW + isc * D; const float* sh = modl + (size_t)mr * MODW + ish * D;
              const f32x4 w4 = *(const f32x4*)(nw + k), s4 = *(const f32x4*)(sc + k), h4 = *(const f32x4*)(sh + k); f32x4 c4;
#pragma unroll
              for (int i = 0; i < 4; ++i) c4[i] = w4[i] * (s4[i] + 1.f);
              const int sl = ((((k >> 9) * 2 + ((k >> 2) & 1)) * 64) + ((k >> 3) & 63)) * 4;
              *(LASP f32x4*)(cs + sl) = c4; *(LASP f32x4*)(ss + sl) = h4; }
            __syncthreads();
            float va[4][8], vb[4][8];
            int row = r0 + 2 * wv;
            if (row < re) norm_load_pair(xc_src, xl_src, src_f32, row, lane, va, vb);
            for (; row < re; row += 16) {
                float na[4][8], nb[4][8];
                if (row + 16 < re) norm_load_pair(xc_src, xl_src, src_f32, row + 16, lane, na, nb);
                __builtin_amdgcn_sched_barrier(0);
                const int rowb = row + 1;
                if (pb != nullptr && row < TC) {
#pragma unroll
                    for (int j = 0; j < 4; ++j) { const int k = j * 512 + lane * 8;
                        const f32x4 p0 = *(const f32x4*)(pb + (size_t)row * D + k), p1 = *(const f32x4*)(pb + (size_t)row * D + k + 4), q0 = *(const f32x4*)(pb + (size_t)rowb * D + k), q1 = *(const f32x4*)(pb + (size_t)rowb * D + k + 4);
#pragma unroll
                        for (int i = 0; i < 4; ++i) { va[j][i] += p0[i]; va[j][4 + i] += p1[i]; vb[j][i] += q0[i]; vb[j][4 + i] += q1[i]; }
                        *(u32x4*)(xc_wb + (size_t)row * D + k) = pack8(va[j]); *(u32x4*)(xc_wb + (size_t)rowb * D + k) = pack8(vb[j]); }
                }
                float sa = 0.f, sb = 0.f;
#pragma unroll
                for (int j = 0; j < 4; ++j)
#pragma unroll
                    for (int i = 0; i < 8; ++i) { sa += va[j][i] * va[j][i]; sb += vb[j][i] * vb[j][i]; }
#pragma unroll
                for (int o = 32; o > 0; o >>= 1) { sa += shx(sa, o, lane); sb += shx(sb, o, lane); }
                const float ra = rsqrtf(sa * (1.f / D) + EPS), rbs = rsqrtf(sb * (1.f / D) + EPS);
#pragma unroll
                for (int j = 0; j < 4; ++j) { const int k = j * 512 + lane * 8; float oa[8], ob[8];
                    const f32x4 c0 = *(const LASP f32x4*)(cs + ((j * 2 + 0) * 64 + lane) * 4), c1 = *(const LASP f32x4*)(cs + ((j * 2 + 1) * 64 + lane) * 4);
                    const f32x4 h0 = *(const LASP f32x4*)(ss + ((j * 2 + 0) * 64 + lane) * 4), h1 = *(const LASP f32x4*)(ss + ((j * 2 + 1) * 64 + lane) * 4);
#pragma unroll
                    for (int i = 0; i < 4; ++i) {
                        oa[i] = va[j][i] * ra * c0[i] + h0[i]; oa[4 + i] = va[j][4 + i] * ra * c1[i] + h1[i];
                        ob[i] = vb[j][i] * rbs * c0[i] + h0[i]; ob[4 + i] = vb[j][4 + i] * rbs * c1[i] + h1[i]; }
                    *(u32x4*)(h + pg8::tiled_off((size_t)row, k, D)) = pack8(oa); *(u32x4*)(h + pg8::tiled_off((size_t)rowb, k, D)) = pack8(ob); }
                __builtin_amdgcn_sched_barrier(0);
#pragma unroll
                for (int j = 0; j < 4; ++j)
#pragma unroll
                    for (int i = 0; i < 8; ++i) { va[j][i] = na[j][i]; vb[j][i] = nb[j][i]; }
            }
            r0 = re;
        }
    }
    __syncthreads();
}
__device__ __forceinline__ void phase_final_norm(int wv, const bf16* x, float* out, const float* nw) {
    const int tid = opaque_tid(wv), lane = tid & 63, wave = wv;
    const int gw = blockIdx.x * 8 + wave, nwv = gridDim.x * 8;
    for (int row = gw; row < TL; row += nwv) {
        float v[4][8]; float ss = 0.f;
#pragma unroll
        for (int j = 0; j < 4; ++j) unpack8(*(const u32x4*)(x + (size_t)row * D + j * 512 + lane * 8), v[j]);
#pragma unroll
        for (int j = 0; j < 4; ++j)
#pragma unroll
            for (int i = 0; i < 8; ++i) ss += v[j][i] * v[j][i];
        ss = wave_sum(ss, lane);
        const float rs = rsqrtf(ss * (1.f / D) + EPS);
#pragma unroll
        for (int j = 0; j < 4; ++j) { const int k = j * 512 + lane * 8; const f32x4 w0 = *(const f32x4*)(nw + k), w1 = *(const f32x4*)(nw + k + 4); f32x4 o0, o1;
#pragma unroll
            for (int i = 0; i < 4; ++i) { o0[i] = v[j][i] * rs * w0[i]; o1[i] = v[j][4 + i] * rs * w1[i]; }
            *(f32x4*)(out + (size_t)row * D + k) = o0; *(f32x4*)(out + (size_t)row * D + k + 4) = o1; }
    }
}

typedef short s16x4 __attribute__((ext_vector_type(4)));
typedef short s16x8 __attribute__((ext_vector_type(8)));
__device__ __forceinline__ s16x4 tr_read4(LASP const unsigned char* p) { return __builtin_amdgcn_ds_read_tr16_b64_v4i16((LASP s16x4*)p); }
__device__ __forceinline__ s16x4 cvt4(const f32x4 v) { u32x2 r; r.x = pg8::cvt_pk_bf16(v[0], v[1]); r.y = pg8::cvt_pk_bf16(v[2], v[3]); return __builtin_bit_cast(s16x4, r); }
__device__ __forceinline__ float logsigmoid_(float x) { return fminf(x, 0.f) - log1p_pos(__expf(-fabsf(x))); }
#define MFMA16(a, b, c) __builtin_amdgcn_mfma_f32_16x16x16bf16_1k((a), (b), (c), 0, 0, 0)
#define MFMA32(a, b, c) __builtin_amdgcn_mfma_f32_16x16x32_bf16((a), (b), (c), 0, 0, 0)

__device__ __forceinline__ void phase_mlstm_chunk(int wv, const bf16* u, const float* gates, const float* gate_b, bf16* so, LASP unsigned char* lds) {
    constexpr int L = 64, NC = (CTX + SEQ) / L, RSQ = 528, RSK = 544, RSV = 288, RSP = 144;
    constexpr int OFF_Q = 0, OFF_K = OFF_Q + L * RSQ, OFF_V = OFF_K + L * RSK, OFF_V2 = OFF_V + L * RSV, OFF_P = OFF_V2 + L * RSV, OFF_F = OFF_P + L * RSP;
    const int tid = opaque_tid(wv), lane = tid & 63, wave = wv, g = lane >> 4, l15 = lane & 15;
    LASP float* fb = (LASP float*)(lds + OFF_F);
    LASP float* s_gv = fb;
    LASP float* s_misc = fb + 512;
    LASP float* s_denp = fb + 520; LASP float* s_qn = fb + 776; LASP float* s_n = fb + 840;
    LASP bf16* s_wb = (LASP bf16*)(fb + 1864);
    for (int item = blockIdx.x; item < BATCH * 4 * 2 * 4; item += gridDim.x) {
        const int b = item >> 5, h = (item >> 3) & 3, dir = (item >> 2) & 1, vq = item & 3;
        const float bi = gate_b[dir * 4 + h], bfg = gate_b[(2 + dir) * 4 + h];
        f32x4 S[16];
#pragma unroll
        for (int j = 0; j < 16; ++j) S[j] = (f32x4){0.f, 0.f, 0.f, 0.f};
        s_n[opaque_tid(wv)] = 0.f;
        f32x4 Nn[2] = {(f32x4){0.f, 0.f, 0.f, 0.f}, (f32x4){0.f, 0.f, 0.f, 0.f}};
        u32x4 pq[4], pk[4], pv[2]; float gi = 0.f, gf = 0.f;
        const int dsq = (dir ? -16 : 16) * OD_MAIN * 2, dsv = (dir ? -32 : 32) * OD_MAIN * 2;
#define MLSTM_LOAD(c) do { const char* ub_ = (const char*)u + (size_t)chunk_row0(b, dir, (c)) * (OD_MAIN * 2); const int t_ = opaque_tid(wv);     \
            const unsigned voq = (unsigned)((rix(dir, t_ >> 5) * OD_MAIN + OU_QK + h * 256 + (t_ & 31) * 8) * 2), vov = (unsigned)((rix(dir, t_ >> 4) * OD_MAIN + OU_V + h * 512 + vq * 128 + (t_ & 15) * 8) * 2); \
            _Pragma("unroll") for (int i = 0; i < 4; ++i) { const char* uq_ = ub_ + (size_t)(unsigned)(voq + i * dsq); pq[i] = *(const u32x4*)uq_; pk[i] = *(const u32x4*)(uq_ + 2048); } \
            _Pragma("unroll") for (int i = 0; i < 2; ++i) pv[i] = *(const u32x4*)(ub_ + (size_t)(unsigned)(vov + i * dsv)); } while (0)
#define MLSTM_GLOAD(c) do { const float* gb_ = gates + (size_t)chunk_row0(b, dir, (c)) * 32 + dir * 4 + h; gi = gb_[rix(dir, lane) * 32]; gf = gb_[rix(dir, lane) * 32 + 8]; } while (0)
#define MLSTM_GPREP(par) do { const float li_ = gi + bi; float x_ = logsigmoid_(gf + bfg); \
            _Pragma("unroll") for (int o = 1; o < 64; o <<= 1) { const float y_ = shup(x_, o, lane); if (lane >= o) x_ += y_; } \
            const float btot_ = rdlane(x_, 63); LASP float* gp_ = s_gv + (par) * 256; \
            const float w_ = __expf(btot_ - x_ + li_); gp_[lane] = x_; gp_[64 + lane] = li_; gp_[128 + lane] = w_; gp_[192 + lane] = __expf(x_); \
            s_wb[(par) * 64 + lane] = (bf16)(pg8::cvt_pk_bf16(w_, 0.f) & 0xffffu); \
            if (lane == 0) s_misc[par] = __expf(btot_); } while (0)
        MLSTM_LOAD(0);
        if (wave == 0) { MLSTM_GLOAD(0); MLSTM_GPREP(0); MLSTM_GLOAD(1); }
        for (int c = 0; c < NC; ++c) {
            const int par = c & 1;
            LASP float* s_b = s_gv + par * 256; LASP float* s_li = s_b + 64; LASP float* s_w = s_b + 128; LASP float* s_eb = s_b + 192;
            LASP float* n_cur = s_n + par * 256; LASP float* n_nxt = s_n + (par ^ 1) * 256;
#pragma unroll
            for (int i = 0; i < 4; ++i) { const int idx = tid + i * 512, r = idx >> 5, pc = idx & 31; *(LASP u32x4*)(lds + OFF_Q + r * RSQ + pc * 16) = pq[i]; *(LASP u32x4*)(lds + OFF_K + r * RSK + pc * 16) = pk[i]; }
#pragma unroll
            for (int i = 0; i < 2; ++i) { const int idx = tid + i * 512, r = idx >> 4, pc = idx & 15; *(LASP u32x4*)(lds + OFF_V + r * RSV + pc * 16) = pv[i]; }
            __syncthreads();
#pragma unroll
            for (int i = 0; i < 2; ++i) { const int idx = tid + i * 512, r = idx >> 4, pc = idx & 15; float v8[8]; unpack8(pv[i], v8); const float w = s_w[r];
#pragma unroll
                for (int j = 0; j < 8; ++j) v8[j] *= w;
                *(LASP u32x4*)(lds + OFF_V2 + r * RSV + pc * 16) = pack8(v8); }
            if (c + 1 < NC) MLSTM_LOAD(c + 1);
            if (wave < 6) {
                const int tb = wave == 0 ? 0 : wave == 1 ? 1 : wave < 4 ? 2 : 3, sb0 = (wave == 3 || wave == 5) ? 2 : 0, ntl = (wave == 0 || wave == 3) ? 1 : 2;
                f32x4 ag0 = (f32x4){0.f, 0.f, 0.f, 0.f}, ag1 = (f32x4){0.f, 0.f, 0.f, 0.f};
#pragma unroll
                for (int kh = 0; kh < 2; ++kh) { s16x8 Gb[4], Ga0[4], Ga1[4];
#pragma unroll
                  for (int ks = 0; ks < 4; ++ks) { Gb[ks] = *(const LASP s16x8*)(lds + OFF_Q + (16 * tb + l15) * RSQ + (kh * 4 + ks) * 64 + g * 16);
                      Ga0[ks] = *(const LASP s16x8*)(lds + OFF_K + (16 * sb0 + l15) * RSK + (kh * 4 + ks) * 64 + g * 16);
                      Ga1[ks] = *(const LASP s16x8*)(lds + OFF_K + (16 * (sb0 + ntl - 1) + l15) * RSK + (kh * 4 + ks) * 64 + g * 16); }
                  __builtin_amdgcn_sched_barrier(0);
#pragma unroll
                  for (int ks = 0; ks < 4; ++ks) { ag0 = MFMA32(Ga0[ks], Gb[ks], ag0); ag1 = MFMA32(Ga1[ks], Gb[ks], ag1); } }
                const int t = 16 * tb + l15; const float bt = s_b[t];
#pragma unroll
                for (int q = 0; q < 2; ++q) { if (q >= ntl) break; const int sb = sb0 + q; const f32x4 ag = q == 0 ? ag0 : ag1; float pvv[4], rs = 0.f;
#pragma unroll
                    for (int i = 0; i < 4; ++i) { const int sidx = 16 * sb + 4 * g + i; pvv[i] = sidx <= t ? ag[i] * __expf(bt - s_b[sidx] + s_li[sidx]) : 0.f; rs += pvv[i]; }
                    u32x2 pk2; pk2.x = pg8::cvt_pk_bf16(pvv[0], pvv[1]); pk2.y = pg8::cvt_pk_bf16(pvv[2], pvv[3]);
                    *(LASP u32x2*)(lds + OFF_P + t * RSP + (16 * sb + 4 * g) * 2) = pk2;
                    rs += shx(rs, 16, lane); rs += shx(rs, 32, lane);
                    if (g == 0) s_denp[sb * 64 + t] = rs; }
                if (wave == 0 && c + 1 < NC) MLSTM_GPREP(par ^ 1);
            } else {
                LASP const float* nsum = n_cur;
                const int t = (wave - 6) * 32 + (lane & 31), kh = lane >> 5; float acc = 0.f;
#pragma unroll
                for (int i = 0; i < 16; ++i) { float q8[8]; unpack8(*(const LASP u32x4*)(lds + OFF_Q + t * RSQ + (kh * 128 + i * 8) * 2), q8);
                    const f32x4 n0 = *(const LASP f32x4*)(nsum + kh * 128 + i * 8), n1 = *(const LASP f32x4*)(nsum + kh * 128 + i * 8 + 4);
                    acc += (q8[0] * n0[0] + q8[1] * n0[1]) + (q8[2] * n0[2] + q8[3] * n0[3]) + (q8[4] * n1[0] + q8[5] * n1[1]) + (q8[6] * n1[2] + q8[7] * n1[3]); }
                acc += shx(acc, 32, lane);
                if (kh == 0) s_qn[t] = acc;
            }
            __syncthreads();
            f32x4 acc[4];
#pragma unroll
            for (int tb = 0; tb < 4; ++tb) acc[tb] = (f32x4){0.f, 0.f, 0.f, 0.f};
            const float gam = s_misc[par];
            {   s16x4 Bc[4], Bn[4], Ac[4], An[4], V2t[4];
#pragma unroll
                for (int sb = 0; sb < 4; ++sb) V2t[sb] = tr_read4(lds + OFF_V2 + (16 * sb + 4 * g + (l15 >> 2)) * RSV + (16 * wave + 4 * (l15 & 3)) * 2);
#define MLSTM_LDB(dst, j) do { _Pragma("unroll") for (int tb = 0; tb < 4; ++tb) \
                    dst[tb] = *(const LASP s16x4*)(lds + OFF_Q + (16 * tb + l15) * RSQ + (16 * (j) + 4 * g) * 2); } while (0)
#define MLSTM_LDA(dst, j) do { _Pragma("unroll") for (int sb = 0; sb < 4; ++sb) \
                    dst[sb] = tr_read4(lds + OFF_K + (16 * sb + 4 * g + (l15 >> 2)) * RSK + (16 * (j) + 4 * (l15 & 3)) * 2); } while (0)
                MLSTM_LDB(Bc, 0); MLSTM_LDA(Ac, 0);
#pragma unroll
                for (int j = 0; j < 16; ++j) {
                    if (j < 15) { MLSTM_LDB(Bn, j + 1); MLSTM_LDA(An, j + 1); }
                    __builtin_amdgcn_sched_barrier(0);
                    { const s16x4 A = cvt4(S[j]);
#pragma unroll
                      for (int tb = 0; tb < 4; ++tb) acc[tb] = MFMA16(A, Bc[tb], acc[tb]);
                      S[j] = S[j] * gam;
#pragma unroll
                      for (int sb = 0; sb < 4; ++sb) S[j] = MFMA16(Ac[sb], V2t[sb], S[j]);
                      if ((j >> 1) == wave) {
                          f32x4 nn = Nn[j & 1] * gam;
#pragma unroll
                          for (int sb = 0; sb < 4; ++sb) nn = MFMA16(Ac[sb], *(const LASP s16x4*)(s_wb + par * 64 + 16 * sb + 4 * g), nn);
                          Nn[j & 1] = nn;
                          if (l15 == 0) *(LASP f32x4*)(n_nxt + 16 * j + 4 * g) = nn; } }
                    __builtin_amdgcn_sched_barrier(0);
#pragma unroll
                    for (int i = 0; i < 4; ++i) { Bc[i] = Bn[i]; Ac[i] = An[i]; }
                }
#undef MLSTM_LDB
#undef MLSTM_LDA
            }
            {   s16x4 Vt[4], Pb[10]; float ebv[4];
#pragma unroll
                for (int sb = 0; sb < 4; ++sb) Vt[sb] = tr_read4(lds + OFF_V + (16 * sb + 4 * g + (l15 >> 2)) * RSV + (16 * wave + 4 * (l15 & 3)) * 2);
#pragma unroll
                for (int tb = 0; tb < 4; ++tb) { ebv[tb] = s_eb[16 * tb + l15];
#pragma unroll
                    for (int sb = 0; sb <= tb; ++sb) Pb[(tb * (tb + 1)) / 2 + sb] = *(const LASP s16x4*)(lds + OFF_P + (16 * tb + l15) * RSP + (16 * sb + 4 * g) * 2); }
                __builtin_amdgcn_sched_barrier(0);
#pragma unroll
                for (int tb = 0; tb < 4; ++tb) { acc[tb] = acc[tb] * ebv[tb];
#pragma unroll
                    for (int sb = 0; sb <= tb; ++sb) acc[tb] = MFMA16(Vt[sb], Pb[(tb * (tb + 1)) / 2 + sb], acc[tb]); }
            }
#pragma unroll
            for (int tb = 0; tb < 4; ++tb) { const int t = 16 * tb + l15; float den = s_eb[t] * s_qn[t];
#pragma unroll
                for (int sb = 0; sb <= tb; ++sb) den += s_denp[sb * 64 + t];
                const float sc = 1.f / fmaxf(fabsf(den), 1.f); const f32x4 o = acc[tb] * sc;
                u32x2 pk2; pk2.x = pg8::cvt_pk_bf16(o[0], o[1]); pk2.y = pg8::cvt_pk_bf16(o[2], o[3]);
                *(u32x2*)((char*)(so + ((size_t)dir * T + chunk_row0(b, dir, c)) * D + h * 512 + vq * 128 + 16 * wave) + (size_t)(unsigned)((rix(dir, t) * D + 4 * g) * 2)) = pk2; }
            if (wave == 0 && c + 2 < NC) MLSTM_GLOAD(c + 2);
            __syncthreads();
        }
#undef MLSTM_LOAD
#undef MLSTM_GLOAD
#undef MLSTM_GPREP
    }
}

__device__ __forceinline__ void phase_ssd_chunk(int wv, const bf16* u, const float* gates, const float* a_log, const float* dt_bias, bf16* so, LASP unsigned char* lds) {
    constexpr int L = 64, RS = 272, RSK = 288, RSP = 144;
    constexpr int OFF_Q = 0, OFF_K = L * RS, OFF_V1 = OFF_K + L * RSK, OFF_V2 = OFF_V1 + L * RSK, OFF_P = OFF_V2 + L * RSK, OFF_F = OFF_P + 2 * L * RSP;
    const int tid = opaque_tid(wv), lane = tid & 63, wave = wv, g = lane >> 4, l15 = lane & 15, hh = wave >> 2;
    LASP float* fb = (LASP float*)(lds + OFF_F);
    LASP float* s_gvv = fb;
    LASP float* s_gm = fb + 1024;
    for (int item = blockIdx.x; item < BATCH * 8 * 2; item += gridDim.x) {
        const int b = item >> 4, hp = (item >> 1) & 7, dir = item & 1, grp = hp >> 2, hA = 2 * hp;
        const float Aneg = -__expf(a_log[dir * 16 + hA + (wave & 1)]), dtb = dt_bias[dir * 16 + hA + (wave & 1)];
        f32x4 S[8];
#pragma unroll
        for (int j = 0; j < 8; ++j) S[j] = (f32x4){0.f, 0.f, 0.f, 0.f};
        u32x4 pq[2], pk[2], pv[2]; float gd = 0.f;
        const int dso = (dir ? -32 : 32) * EV_MAIN * 2;
#define SSD_LOAD(c) do { const char* ub_ = (const char*)u + (size_t)chunk_row0(b, dir, (c)) * (EV_MAIN * 2); const int t_ = opaque_tid(wv); \
            const unsigned vo = (unsigned)((rix(dir, t_ >> 4) * EV_MAIN + EU_XBC + (t_ & 15) * 8) * 2); \
            _Pragma("unroll") for (int i = 0; i < 2; ++i) { const char* ur_ = ub_ + (size_t)(unsigned)(vo + i * dso); \
                pq[i] = *(const u32x4*)(ur_ + (1280 + grp * 128) * 2); pk[i] = *(const u32x4*)(ur_ + (1024 + grp * 128) * 2); pv[i] = *(const u32x4*)(ur_ + hA * 64 * 2); } \
            } while (0)
#define SSD_GLOAD(c) do { gd = gates[((size_t)chunk_row0(b, dir, (c)) + rix(dir, lane)) * 32 + dir * 16 + hA + (wave & 1)]; } while (0)
#define SSD_GPREP(par) do { const float dtv_ = softplus_(gd + dtb); float x_ = Aneg * dtv_; \
            _Pragma("unroll") for (int o = 1; o < 64; o <<= 1) { const float y_ = shup(x_, o, lane); if (lane >= o) x_ += y_; } \
            const float btot_ = rdlane(x_, 63); LASP float* gp_ = s_gvv + (par) * 512 + (wave & 1) * 64; \
            gp_[lane] = dtv_; gp_[128 + lane] = x_; gp_[256 + lane] = __expf(x_); gp_[384 + lane] = __expf(btot_ - x_); \
            if (lane == 0) s_gm[(par) * 2 + (wave & 1)] = __expf(btot_); } while (0)
        SSD_LOAD(0);
        if (wave >= 6) { SSD_GLOAD(0); SSD_GPREP(0); SSD_GLOAD(1); }
        for (int c = 0; c < (CTX + SEQ) / L; ++c) {
            const int par = c & 1;
            LASP float* s_dt = s_gvv + par * 512; LASP float* s_b = s_dt + 128; LASP float* s_eb = s_dt + 256; LASP float* s_w = s_dt + 384; LASP float* s_gam = s_gm + par * 2;
#pragma unroll
            for (int i = 0; i < 2; ++i) { const int idx = tid + i * 512, r = idx >> 4, pc = idx & 15; *(LASP u32x4*)(lds + OFF_Q + r * RS + pc * 16) = pq[i]; *(LASP u32x4*)(lds + OFF_K + r * RSK + pc * 16) = pk[i]; }
            __syncthreads();
#pragma unroll
            for (int i = 0; i < 2; ++i) { const int idx = tid + i * 512, r = idx >> 4, pc = idx & 15, hc = pc >> 3; const float dtv = s_dt[hc * 64 + r], w = s_w[hc * 64 + r];
                float x8[8]; unpack8(pv[i], x8);
#pragma unroll
                for (int j = 0; j < 8; ++j) x8[j] *= dtv;
                *(LASP u32x4*)(lds + OFF_V1 + r * RSK + pc * 16) = pack8(x8);
#pragma unroll
                for (int j = 0; j < 8; ++j) x8[j] *= w;
                *(LASP u32x4*)(lds + OFF_V2 + r * RSK + pc * 16) = pack8(x8); }
            if (c + 1 < (CTX + SEQ) / L) SSD_LOAD(c + 1);
            if (wave < 6) {
                const int tb = wave == 0 ? 0 : wave == 1 ? 1 : wave < 4 ? 2 : 3, sb0 = (wave == 3 || wave == 5) ? 2 : 0, ntl = (wave == 0 || wave == 3) ? 1 : 2;
                f32x4 ag0 = (f32x4){0.f, 0.f, 0.f, 0.f}, ag1 = (f32x4){0.f, 0.f, 0.f, 0.f};
                { s16x8 Gb[4], Ga0[4], Ga1[4];
#pragma unroll
                  for (int ks = 0; ks < 4; ++ks) { Gb[ks] = *(const LASP s16x8*)(lds + OFF_Q + (16 * tb + l15) * RS + ks * 64 + g * 16);
                      Ga0[ks] = *(const LASP s16x8*)(lds + OFF_K + (16 * sb0 + l15) * RSK + ks * 64 + g * 16);
                      Ga1[ks] = *(const LASP s16x8*)(lds + OFF_K + (16 * (sb0 + ntl - 1) + l15) * RSK + ks * 64 + g * 16); }
                  __builtin_amdgcn_sched_barrier(0);
#pragma unroll
                  for (int ks = 0; ks < 4; ++ks) { ag0 = MFMA32(Ga0[ks], Gb[ks], ag0); ag1 = MFMA32(Ga1[ks], Gb[ks], ag1); } }
                const int t = 16 * tb + l15;
#pragma unroll
                for (int q = 0; q < 2; ++q) { if (q >= ntl) break; const int sb = sb0 + q; const f32x4 ag = q == 0 ? ag0 : ag1;
#pragma unroll
                    for (int hd = 0; hd < 2; ++hd) { const float bt = s_b[hd * 64 + t]; float pvv[4];
#pragma unroll
                        for (int i = 0; i < 4; ++i) { const int sidx = 16 * sb + 4 * g + i; pvv[i] = sidx <= t ? ag[i] * __expf(bt - s_b[hd * 64 + sidx]) : 0.f; }
                        u32x2 pk2; pk2.x = pg8::cvt_pk_bf16(pvv[0], pvv[1]); pk2.y = pg8::cvt_pk_bf16(pvv[2], pvv[3]);
                        *(LASP u32x2*)(lds + OFF_P + hd * L * RSP + t * RSP + (16 * sb + 4 * g) * 2) = pk2; } }
            } else if (c + 1 < (CTX + SEQ) / L) SSD_GPREP(par ^ 1);
            __syncthreads();
            f32x4 acc[4];
#pragma unroll
            for (int tb = 0; tb < 4; ++tb) acc[tb] = (f32x4){0.f, 0.f, 0.f, 0.f};
            {   s16x4 Bc[16], Bn[16];
#define SSD_LDB(dst, jb) do { _Pragma("unroll") for (int jj = 0; jj < 4; ++jj) _Pragma("unroll") for (int tb = 0; tb < 4; ++tb) \
                    dst[jj * 4 + tb] = *(const LASP s16x4*)(lds + OFF_Q + (16 * tb + l15) * RS + (16 * ((jb) * 4 + jj) + 4 * g) * 2); } while (0)
                SSD_LDB(Bc, 0);
#pragma unroll
                for (int jb = 0; jb < 2; ++jb) {
                    if (jb < 1) SSD_LDB(Bn, jb + 1);
                    __builtin_amdgcn_sched_barrier(0);
#pragma unroll
                    for (int jj = 0; jj < 4; ++jj) { const s16x4 A = cvt4(S[jb * 4 + jj]);
#pragma unroll
                        for (int tb = 0; tb < 4; ++tb) acc[tb] = MFMA16(A, Bc[jj * 4 + tb], acc[tb]); }
                    __builtin_amdgcn_sched_barrier(0);
#pragma unroll
                    for (int i = 0; i < 16; ++i) Bc[i] = Bn[i];
                }
#undef SSD_LDB
            }
            s16x4 Vt[4];
            {   s16x4 Pb[10]; float ebv[4];
#pragma unroll
                for (int sb = 0; sb < 4; ++sb) Vt[sb] = tr_read4(lds + OFF_V1 + (16 * sb + 4 * g + (l15 >> 2)) * RSK + (16 * wave + 4 * (l15 & 3)) * 2);
#pragma unroll
                for (int tb = 0; tb < 4; ++tb) { ebv[tb] = s_eb[hh * 64 + 16 * tb + l15];
#pragma unroll
                    for (int sb = 0; sb <= tb; ++sb) Pb[(tb * (tb + 1)) / 2 + sb] = *(const LASP s16x4*)(lds + OFF_P + hh * L * RSP + (16 * tb + l15) * RSP + (16 * sb + 4 * g) * 2); }
                __builtin_amdgcn_sched_barrier(0);
#pragma unroll
                for (int tb = 0; tb < 4; ++tb) { acc[tb] = acc[tb] * ebv[tb];
#pragma unroll
                    for (int sb = 0; sb <= tb; ++sb) acc[tb] = MFMA16(Vt[sb], Pb[(tb * (tb + 1)) / 2 + sb], acc[tb]); }
            }
#pragma unroll
            for (int tb = 0; tb < 4; ++tb) { const int t = 16 * tb + l15; const f32x4 o = acc[tb];
                u32x2 pk2; pk2.x = pg8::cvt_pk_bf16(o[0], o[1]); pk2.y = pg8::cvt_pk_bf16(o[2], o[3]);
                *(u32x2*)((char*)(so + ((size_t)dir * T + chunk_row0(b, dir, c)) * D + hA * 64 + 16 * wave) + (size_t)(unsigned)((rix(dir, t) * D + 4 * g) * 2)) = pk2; }
#pragma unroll
            for (int sb = 0; sb < 4; ++sb) Vt[sb] = tr_read4(lds + OFF_V2 + (16 * sb + 4 * g + (l15 >> 2)) * RSK + (16 * wave + 4 * (l15 & 3)) * 2);
            if (wave >= 6 && c + 2 < (CTX + SEQ) / L) SSD_GLOAD(c + 2);
            const float gam = s_gam[hh];
            {   s16x4 Ac[16], An[16];
#define SSD_LDA(dst, jb) do { _Pragma("unroll") for (int jj = 0; jj < 4; ++jj) _Pragma("unroll") for (int sb = 0; sb < 4; ++sb) \
                    dst[jj * 4 + sb] = tr_read4(lds + OFF_K + (16 * sb + 4 * g + (l15 >> 2)) * RSK + (16 * ((jb) * 4 + jj) + 4 * (l15 & 3)) * 2); } while (0)
                SSD_LDA(Ac, 0);
#pragma unroll
                for (int jb = 0; jb < 2; ++jb) {
                    if (jb < 1) SSD_LDA(An, jb + 1);
                    __builtin_amdgcn_sched_barrier(0);
#pragma unroll
                    for (int jj = 0; jj < 4; ++jj) { S[jb * 4 + jj] = S[jb * 4 + jj] * gam;
#pragma unroll
                        for (int sb = 0; sb < 4; ++sb) S[jb * 4 + jj] = MFMA16(Ac[jj * 4 + sb], Vt[sb], S[jb * 4 + jj]); }
                    __builtin_amdgcn_sched_barrier(0);
#pragma unroll
                    for (int i = 0; i < 16; ++i) Ac[i] = An[i];
                }
#undef SSD_LDA
            }
            __syncthreads();
        }
#undef SSD_LOAD
#undef SSD_GLOAD
#undef SSD_GPREP
    }
}

__device__ __forceinline__ void phase_hgrn_chunk(int wv, const bf16* u, const float* hlb, int e, bf16* so, LASP unsigned char* lds) {
    constexpr int L = 64, RS = 272, RSK = 288, RSP = 40;
    constexpr int OFF_Z = 0  , OFF_Q = L * RS  , OFF_KP = 2 * L * RS, OFF_V = OFF_KP + L * RSK, OFF_P = OFF_V + L * RSK, OFF_G = OFF_P + 4 * 16 * RSP;
    const int tid = opaque_tid(wv), lane = tid & 63, wave = wv, g = lane >> 4, l15 = lane & 15;
    LASP float* s_g = (LASP float*)(lds + OFF_G);
    for (int item = blockIdx.x; item < BATCH * 8 * 2; item += gridDim.x) {
        const int b = item >> 4, h = (item >> 1) & 7, dir = item & 1;
        const int ep = tid & 63, esub = (tid >> 6) & 3;
        f32x2 lb2 = (f32x2){0.f, 0.f};
        if (e != 0) { lb2.x = sigmoid_(hlb[1024 + h * 128 + 2 * ep] - hlb[h * 128 + 2 * ep]); lb2.y = sigmoid_(hlb[1024 + h * 128 + 2 * ep + 1] - hlb[h * 128 + 2 * ep + 1]); }
        const f32x2 oml2 = (f32x2){1.f, 1.f} - lb2;
        f32x4 S[8];
#pragma unroll
        for (int j = 0; j < 8; ++j) S[j] = (f32x4){0.f, 0.f, 0.f, 0.f};
        u32x4 pz[2], pq[2], pv[2];
        const int dso = (dir ? -32 : 32) * EV_MAIN * 2;
#define HGRN_LOAD(c) do { const char* ub_ = (const char*)u + (size_t)chunk_row0(b, dir, (c)) * (EV_MAIN * 2); const int t_ = opaque_tid(wv); \
            const unsigned vo = (unsigned)((rix(dir, t_ >> 4) * EV_MAIN + h * 128 + (t_ & 15) * 8) * 2); \
            _Pragma("unroll") for (int i = 0; i < 2; ++i) { const char* ur_ = ub_ + (size_t)(unsigned)(vo + i * dso); \
                pz[i] = *(const u32x4*)(ur_ + (EU_F + dir * 1024) * 2); pq[i] = *(const u32x4*)(ur_ + EU_Q * 2); pv[i] = *(const u32x4*)(ur_ + EU_I * 2); } } while (0)
        HGRN_LOAD(0);
        for (int c = 0; c < (CTX + SEQ) / L; ++c) {
#pragma unroll
            for (int i = 0; i < 2; ++i) { const int idx = tid + i * 512, r = idx >> 4, pc = idx & 15;
                *(LASP u32x4*)(lds + OFF_Z + r * RS + pc * 16) = pz[i]; *(LASP u32x4*)(lds + OFF_Q + r * RS + pc * 16) = pq[i]; *(LASP u32x4*)(lds + OFF_V + r * RSK + pc * 16) = pv[i]; }
            __syncthreads();
            if (c + 1 < (CTX + SEQ) / L) HGRN_LOAD(c + 1);
            if (wave < 4) { f32x2 pf[16], kin[16]; f32x2 run = (f32x2){1.f, 1.f};
#pragma unroll
              for (int t = 0; t < 16; ++t) { const unsigned zw = *(const LASP unsigned*)(lds + OFF_Z + (esub * 16 + t) * RS + ep * 4);
                  const f32x2 zf = (f32x2){fminf(bf_lo(zw), 30.f), fminf(bf_hi(zw), 30.f)};
                  const f32x2 ez = (f32x2){__expf(zf.x), __expf(zf.y)}, sneg = (f32x2){__builtin_amdgcn_rcpf(1.f + ez.x), __builtin_amdgcn_rcpf(1.f + ez.y)}, spos = ez * sneg;
                  const f32x2 f = lb2 + oml2 * spos; kin[t] = oml2 * sneg; run = run * f; run.x = fmaxf(run.x, 1e-30f); run.y = fmaxf(run.y, 1e-30f); pf[t] = run; }
#pragma unroll
              for (int t = 0; t < 16; ++t) { LASP unsigned* zp = (LASP unsigned*)(lds + OFF_Z + (esub * 16 + t) * RS + ep * 4); LASP unsigned* qp = (LASP unsigned*)(lds + OFF_Q + (esub * 16 + t) * RS + ep * 4);
                  LASP unsigned* kp = (LASP unsigned*)(lds + OFF_KP + (esub * 16 + t) * RSK + ep * 4);
                  const unsigned qw = *qp; const f32x2 qr = (f32x2){bf_lo(qw), bf_hi(qw)};
                  const f32x2 sg = (f32x2){__builtin_amdgcn_rcpf(1.f + __expf(-qr.x)), __builtin_amdgcn_rcpf(1.f + __expf(-qr.y))}, q = qr * sg * pf[t];
                  const f32x2 ipf = (f32x2){__builtin_amdgcn_rcpf(pf[t].x), __builtin_amdgcn_rcpf(pf[t].y)}, ks = kin[t] * ipf, kpv = ks * run;
                  *qp = pg8::cvt_pk_bf16(q.x, q.y); *zp = pg8::cvt_pk_bf16(ks.x, ks.y); *kp = pg8::cvt_pk_bf16(kpv.x, kpv.y); }
              *(LASP f32x2*)(s_g + esub * 128 + 2 * ep) = run; }
            __syncthreads();
            if (wave < 4) {
                f32x4 ag = (f32x4){0.f, 0.f, 0.f, 0.f};
#pragma unroll
                for (int ks = 0; ks < 4; ++ks) {
                    const s16x8 A = *(const LASP s16x8*)(lds + OFF_Z + (16 * wave + l15) * RS + ks * 64 + g * 16);
                    const s16x8 B = *(const LASP s16x8*)(lds + OFF_Q + (16 * wave + l15) * RS + ks * 64 + g * 16);
                    ag = MFMA32(A, B, ag);
                }
                float pvv[4];
#pragma unroll
                for (int i = 0; i < 4; ++i) pvv[i] = (4 * g + i) <= l15 ? ag[i] : 0.f;
                u32x2 pk2; pk2.x = pg8::cvt_pk_bf16(pvv[0], pvv[1]); pk2.y = pg8::cvt_pk_bf16(pvv[2], pvv[3]);
                *(LASP u32x2*)(lds + OFF_P + wave * 16 * RSP + l15 * RSP + 8 * g) = pk2;
            }
            __syncthreads();
#pragma unroll
            for (int sub = 0; sub < 4; ++sub) {
                f32x4 acc = (f32x4){0.f, 0.f, 0.f, 0.f};
                s16x4 Bq[8], Ak[8]; f32x4 gsv[8];
#pragma unroll
                for (int j = 0; j < 8; ++j) Bq[j] = *(const LASP s16x4*)(lds + OFF_Q + (16 * sub + l15) * RS + (16 * j + 4 * g) * 2);
                const s16x4 Vt = tr_read4(lds + OFF_V + (16 * sub + 4 * g + (l15 >> 2)) * RSK + (16 * wave + 4 * (l15 & 3)) * 2);
                const s16x4 Pt = *(const LASP s16x4*)(lds + OFF_P + sub * 16 * RSP + l15 * RSP + 8 * g);
#pragma unroll
                for (int j = 0; j < 8; ++j) { Ak[j] = tr_read4(lds + OFF_KP + (16 * sub + 4 * g + (l15 >> 2)) * RSK + (16 * j + 4 * (l15 & 3)) * 2); gsv[j] = *(const LASP f32x4*)(s_g + sub * 128 + 16 * j + 4 * g); }
                __builtin_amdgcn_sched_barrier(0);
                f32x4 acc2 = (f32x4){0.f, 0.f, 0.f, 0.f};
#pragma unroll
                for (int j = 0; j < 8; j += 2) { acc = MFMA16(cvt4(S[j]), Bq[j], acc); acc2 = MFMA16(cvt4(S[j + 1]), Bq[j + 1], acc2); }
                acc2 = MFMA16(Vt, Pt, acc2);
                acc = acc + acc2;
                { u32x2 pk2; pk2.x = pg8::cvt_pk_bf16(acc[0], acc[1]); pk2.y = pg8::cvt_pk_bf16(acc[2], acc[3]);
                  *(u32x2*)((char*)(so + ((size_t)dir * T + chunk_row0(b, dir, c)) * D + 1024 + h * 128 + 16 * wave) + (size_t)(unsigned)((rix(dir, 16 * sub + l15) * D + 4 * g) * 2)) = pk2; }
#pragma unroll
                for (int j = 0; j < 8; ++j) S[j] = MFMA16(Ak[j], Vt, S[j] * gsv[j]);
            }
            __syncthreads();
        }
#undef HGRN_LOAD
    }
}

__device__ __forceinline__ void phase_out_even(int wv, const bf16* u, const bf16* so, const float* dskip, const float* ssd_nw, const float* hgrn_nw, bf16* y, int row_lo) {
    const int tid = opaque_tid(wv), lane = tid & 63, wave = wv;
    const int gw = blockIdx.x * 8 + wave, nwv = gridDim.x * 8;
    for (int row = row_lo + gw; row < T; row += nwv) {
        const bf16* ur = u + (size_t)row * EV_MAIN; const bf16* sr = so + (size_t)row * D; const bf16* sr2 = so + ((size_t)T + row) * D;
        u32x4 rxs[2], rz[2], rg[2], rsa[4], rsb[4]; f32x4 nwa[4][2];
#pragma unroll
        for (int j = 0; j < 2; ++j) { const int c = j * 512 + lane * 8; rxs[j] = *(const u32x4*)(ur + EU_XBC + c); rz[j] = *(const u32x4*)(ur + EU_Z + c); rg[j] = *(const u32x4*)(ur + EU_G + c);
            nwa[j][0] = *(const f32x4*)(ssd_nw + c); nwa[j][1] = *(const f32x4*)(ssd_nw + c + 4); nwa[2 + j][0] = *(const f32x4*)(hgrn_nw + c); nwa[2 + j][1] = *(const f32x4*)(hgrn_nw + c + 4); }
#pragma unroll
        for (int j = 0; j < 4; ++j) { const int c = j * 512 + lane * 8; rsa[j] = *(const u32x4*)(sr + c); rsb[j] = *(const u32x4*)(sr2 + c); }
#pragma unroll
        for (int j = 0; j < 2; ++j) {
            const int c = j * 512 + lane * 8;
            float xs[8], z[8], val[8], sa[8], sb[8]; unpack8(rxs[j], xs); unpack8(rz[j], z); unpack8(rsa[j], sa); unpack8(rsb[j], sb);
            const float dsk = dskip[c >> 6]; float ss = 0.f;
#pragma unroll
            for (int i = 0; i < 8; ++i) { const float yy = (sa[i] + sb[i]) + xs[i] * dsk; val[i] = yy * silu_(z[i]); ss += val[i] * val[i]; }
            ss = wave_sum(ss, lane);
            const float rs = rsqrtf(ss * (1.f / 512.f) + EPS);
#pragma unroll
            for (int i = 0; i < 8; ++i) val[i] = val[i] * rs * (i < 4 ? nwa[j][0][i] : nwa[j][1][i - 4]);
            *(u32x4*)(y + pg8::tiled_off((size_t)row, c, D)) = pack8(val);
        }
#pragma unroll
        for (int j = 0; j < 2; ++j) {
            const int c = j * 512 + lane * 8;
            float gg[8], val[8], sa[8], sb[8]; unpack8(rg[j], gg); unpack8(rsa[2 + j], sa); unpack8(rsb[2 + j], sb);
            float ss = 0.f;
#pragma unroll
            for (int i = 0; i < 8; ++i) { val[i] = sa[i] + sb[i]; ss += val[i] * val[i]; }
            ss += shx(ss, 1, lane); ss += shx(ss, 2, lane); ss += shx(ss, 4, lane); ss += shx(ss, 8, lane);
            const float rs = rsqrtf(ss * (1.f / 128.f) + EPS);
#pragma unroll
            for (int i = 0; i < 8; ++i) val[i] = val[i] * rs * (i < 4 ? nwa[2 + j][0][i] : nwa[2 + j][1][i - 4]) * silu_(gg[i]);
            *(u32x4*)(y + pg8::tiled_off((size_t)row, 1024 + c, D)) = pack8(val);
        }
    }
}
__device__ __forceinline__ void phase_out_odd(int wv, const bf16* u, const bf16* so, const float* nw, bf16* y, int row_lo) {
    const int tid = opaque_tid(wv), lane = tid & 63, wave = wv;
    const int gw = blockIdx.x * 8 + wave, nwv = gridDim.x * 8;
    for (int row = row_lo + gw; row < T; row += nwv) {
        const bf16* ur = u + (size_t)row * OD_MAIN; const bf16* sr = so + (size_t)row * D; const bf16* sr2 = so + ((size_t)T + row) * D;
        u32x4 rog[4], rsa[4], rsb[4]; f32x4 nwa[4][2];
#pragma unroll
        for (int j = 0; j < 4; ++j) { const int c = j * 512 + lane * 8; rog[j] = *(const u32x4*)(ur + OU_O + c); rsa[j] = *(const u32x4*)(sr + c); rsb[j] = *(const u32x4*)(sr2 + c);
            nwa[j][0] = *(const f32x4*)(nw + c); nwa[j][1] = *(const f32x4*)(nw + c + 4); }
#pragma unroll
        for (int j = 0; j < 4; ++j) {
            const int c = j * 512 + lane * 8;
            float og[8], val[8], sa[8], sb[8]; unpack8(rog[j], og); unpack8(rsa[j], sa); unpack8(rsb[j], sb);
            float ss = 0.f;
#pragma unroll
            for (int i = 0; i < 8; ++i) { val[i] = sa[i] + sb[i]; ss += val[i] * val[i]; }
            ss = wave_sum(ss, lane);
            const float rs = rsqrtf(ss * (1.f / 512.f) + EPS);
#pragma unroll
            for (int i = 0; i < 8; ++i) val[i] = val[i] * rs * (i < 4 ? nwa[j][0][i] : nwa[j][1][i - 4]) * sigmoid_(og[i]);
            *(u32x4*)(y + pg8::tiled_off((size_t)row, c, D)) = pack8(val);
        }
    }
}

__device__ __forceinline__ float dpp_ror1(float v) { return __int_as_float(__builtin_amdgcn_update_dpp(0, __float_as_int(v), 0x121, 0xf, 0xf, false)); }
__device__ __forceinline__ float dpp_rol1(float v) { return __int_as_float(__builtin_amdgcn_update_dpp(0, __float_as_int(v), 0x12f, 0xf, 0xf, false)); }
struct EpiU {
    static constexpr bool PERM = true, AFTER_DRAIN = false;
    bf16* U; int ldu; int n_main; float* gates;
    const float* cw; const float* cb; int cv_lo, cv_hi, nch, ks_pn; LASP unsigned char* lds;
    __device__ __forceinline__ void operator()(const f32x4 (&acc)[2][2][4][2], const pg8::Unit& u, int wr, int wc, int fr, int fq) const {
        int row0 = u.pm * 256 + wr * 64 + fr; asm volatile("" : "+v"(row0));
        if (u.pn < n_main) {
            const int col0 = u.pn * 256 + wc * 32 + 8 * fq;
            if (u.pn < cv_lo || u.pn >= cv_hi) {
#pragma unroll
                for (int ai = 0; ai < 2; ++ai)
#pragma unroll
                    for (int m = 0; m < 4; ++m) { bf16* rowp = U + (size_t)(row0 + ai * 128 + m * 16) * ldu + col0;
#pragma unroll
                        for (int bj = 0; bj < 2; ++bj) { const f32x4 v0 = acc[ai][bj][m][0], v1 = acc[ai][bj][m][1];
                            u32x4 w; w.x = pg8::cvt_pk_bf16(v0[0], v0[1]); w.y = pg8::cvt_pk_bf16(v0[2], v0[3]); w.z = pg8::cvt_pk_bf16(v1[0], v1[1]); w.w = pg8::cvt_pk_bf16(v1[2], v1[3]);
                            *(u32x4*)(rowp + bj * 128) = w; } }
            } else {
                const bool ctx = u.pm < 16; const float post = u.pn >= ks_pn ? 0.0625f : 1.f;
                const int lc0 = wc * 32 + 8 * fq, ch0 = (u.pn - cv_lo) * 256 + lc0;
                LASP float* EX = (LASP float*)(lds + 131072);
                if (ctx) {
#pragma unroll
                    for (int ai = 0; ai < 2; ++ai) { const int k = ai * 2 + wr;
#pragma unroll
                        for (int bj = 0; bj < 2; ++bj)
#pragma unroll
                            for (int n = 0; n < 2; ++n) {
                                if (fr == 0) *(LASP f32x4*)(EX + (k * 2 + 0) * 256 + bj * 128 + lc0 + 4 * n) = acc[ai][bj][0][n];
                                if (fr == 15) *(LASP f32x4*)(EX + (k * 2 + 1) * 256 + bj * 128 + lc0 + 4 * n) = acc[ai][bj][3][n]; } }
                    asm volatile("s_waitcnt lgkmcnt(0)" ::: "memory"); __builtin_amdgcn_s_barrier(); asm volatile("" ::: "memory");
                }
#pragma unroll
                for (int bj = 0; bj < 2; ++bj) {
                    f32x4 w0[2], w1[2], w2[2], bb[2];
#pragma unroll
                    for (int n = 0; n < 2; ++n) { const int ch = ch0 + bj * 128 + 4 * n;
                        w0[n] = *(const f32x4*)(cw + ch); w1[n] = *(const f32x4*)(cw + nch + ch); w2[n] = *(const f32x4*)(cw + 2 * nch + ch); bb[n] = *(const f32x4*)(cb + ch); }
#pragma unroll
                    for (int ai = 0; ai < 2; ++ai) { const int k = ai * 2 + wr;
                        f32x4 bprev[2], bnext[2];
#pragma unroll
                        for (int n = 0; n < 2; ++n) { bprev[n] = (f32x4){0.f, 0.f, 0.f, 0.f}; bnext[n] = (f32x4){0.f, 0.f, 0.f, 0.f};
                            if (ctx) { if (k > 0) bprev[n] = *(const LASP f32x4*)(EX + ((k - 1) * 2 + 1) * 256 + bj * 128 + lc0 + 4 * n);
                                       if (k < 3) bnext[n] = *(const LASP f32x4*)(EX + ((k + 1) * 2 + 0) * 256 + bj * 128 + lc0 + 4 * n); } }
#pragma unroll
                        for (int m = 0; m < 4; ++m) { float o[2][4];
#pragma unroll
                            for (int n = 0; n < 2; ++n)
#pragma unroll
                                for (int i = 0; i < 4; ++i) {
                                    const float rs_ = dpp_ror1(acc[ai][bj][m][n][i]), rp_ = m > 0 ? dpp_ror1(acc[ai][bj][m > 0 ? m - 1 : 0][n][i]) : bprev[n][i];
                                    const float ls_ = dpp_rol1(acc[ai][bj][m][n][i]), ln_ = m < 3 ? dpp_rol1(acc[ai][bj][m < 3 ? m + 1 : 3][n][i]) : bnext[n][i];
                                    const float pv = fr == 0 ? rp_ : rs_, nx = fr == 15 ? ln_ : ls_;
                                    const float a = bb[n][i] + w0[n][i] * pv + w1[n][i] * acc[ai][bj][m][n][i] + w2[n][i] * nx;
                                    o[n][i] = a * __builtin_amdgcn_rcpf(1.f + __expf(-a)) * post; }
                            u32x4 w; w.x = pg8::cvt_pk_bf16(o[0][0], o[0][1]); w.y = pg8::cvt_pk_bf16(o[0][2], o[0][3]); w.z = pg8::cvt_pk_bf16(o[1][0], o[1][1]); w.w = pg8::cvt_pk_bf16(o[1][2], o[1][3]);
                            *(u32x4*)(U + (size_t)(row0 + ai * 128 + m * 16) * ldu + col0 + bj * 128) = w; } } }
            }
        } else if (wc == 0) {
#pragma unroll
            for (int ai = 0; ai < 2; ++ai)
#pragma unroll
                for (int m = 0; m < 4; ++m) { float* gp = gates + (size_t)(row0 + ai * 128 + m * 16) * 32 + 8 * fq;
                    *(f32x4*)gp = acc[ai][0][m][0]; *(f32x4*)(gp + 4) = acc[ai][0][m][1]; }
        }
    }
};
struct EpiAct {
    static constexpr bool PERM = true, AFTER_DRAIN = false;
    bf16* O; int ldc;
    __device__ __forceinline__ void operator()(const f32x4 (&acc)[2][2][4][2], const pg8::Unit& u, int wr, int wc, int fr, int fq) const {
        int row0 = u.pm * 256 + wr * 64 + fr; asm volatile("" : "+v"(row0)); const int col0 = u.pn * 256 + wc * 32 + 8 * fq;
#pragma unroll
        for (int ai = 0; ai < 2; ++ai)
#pragma unroll
            for (int m = 0; m < 4; ++m) { bf16* rowp = O + pg8::tiled_off((size_t)(row0 + ai * 128 + m * 16), col0, ldc);
#pragma unroll
                for (int bj = 0; bj < 2; ++bj) { f32x4 v0 = acc[ai][bj][m][0], v1 = acc[ai][bj][m][1];
#pragma unroll
                    for (int i = 0; i < 4; ++i) { const float a = fmaxf(v0[i], 0.f), b = fmaxf(v1[i], 0.f); v0[i] = a * a; v1[i] = b * b; }
                    u32x4 w; w.x = pg8::cvt_pk_bf16(v0[0], v0[1]); w.y = pg8::cvt_pk_bf16(v0[2], v0[3]); w.z = pg8::cvt_pk_bf16(v1[0], v1[1]); w.w = pg8::cvt_pk_bf16(v1[2], v1[3]);
                    *(u32x4*)(rowp + bj * (2 * 256 * 64)) = w; } }
    }
};
struct EpiRes {
    static constexpr bool PERM = true, AFTER_DRAIN = false;
    const void* xc_in; bf16* xc_out; const void* xl_in; bf16* xl_out; int in_f32; const float* gate_base; int pm_off; float* pb;
    __device__ __forceinline__ void operator()(const f32x4 (&acc)[2][2][4][2], const pg8::Unit& u, int wr, int wc, int fr, int fq) const {
        const int pmg = u.pm + pm_off;
        const void* rin; bf16* rout; int gr; size_t rbase;
        if (pmg < 16) { rin = xc_in; rout = xc_out; rbase = (size_t)pmg * 256; gr = 16; }
        else { rin = xl_in; rout = xl_out; rbase = (size_t)(pmg - 16) * 256; gr = (pmg - 16) >> 3; }
        const float* gate = gate_base + (size_t)gr * MODW;
        int row0 = wr * 64 + fr; asm volatile("" : "+v"(row0)); const int col0 = u.pn * 256 + wc * 32 + 8 * fq;
        f32x4 gv[2][2];
#pragma unroll
        for (int bj = 0; bj < 2; ++bj)
#pragma unroll
            for (int n = 0; n < 2; ++n) gv[bj][n] = *(const f32x4*)(gate + col0 + bj * 128 + n * 4);
        if (u.part == 2) {
            float* po = pb + (size_t)pmg * 256 * D;
#pragma unroll
            for (int ai = 0; ai < 2; ++ai)
#pragma unroll
                for (int m = 0; m < 4; ++m) { const size_t off = (size_t)(row0 + ai * 128 + m * 16) * D + col0;
#pragma unroll
                    for (int bj = 0; bj < 2; ++bj)
#pragma unroll
                        for (int n = 0; n < 2; ++n) *(f32x4*)(po + off + bj * 128 + n * 4) = gv[bj][n] * acc[ai][bj][m][n]; }
            return;
        }
        if (in_f32) {
#pragma unroll
            for (int ai = 0; ai < 2; ++ai)
#pragma unroll
                for (int m = 0; m < 4; ++m) { const size_t off = (rbase + row0 + ai * 128 + m * 16) * D + col0; float r[2][8];
#pragma unroll
                    for (int bj = 0; bj < 2; ++bj) load_x8(rin, true, off + bj * 128, r[bj]);
#pragma unroll
                    for (int bj = 0; bj < 2; ++bj) {
#pragma unroll
                        for (int i = 0; i < 4; ++i) { r[bj][i] += gv[bj][0][i] * acc[ai][bj][m][0][i]; r[bj][4 + i] += gv[bj][1][i] * acc[ai][bj][m][1][i]; }
                        *(u32x4*)(rout + off + bj * 128) = pack8(r[bj]); } }
        } else {
            u32x4 xr[2][4][2];
#pragma unroll
            for (int ai = 0; ai < 2; ++ai)
#pragma unroll
                for (int m = 0; m < 4; ++m)
#pragma unroll
                    for (int bj = 0; bj < 2; ++bj) xr[ai][m][bj] = *(const u32x4*)((const bf16*)rin + (rbase + row0 + ai * 128 + m * 16) * D + col0 + bj * 128);
#pragma unroll
            for (int ai = 0; ai < 2; ++ai)
#pragma unroll
                for (int m = 0; m < 4; ++m) { const size_t off = (rbase + row0 + ai * 128 + m * 16) * D + col0;
#pragma unroll
                    for (int bj = 0; bj < 2; ++bj) { float r[8]; unpack8(xr[ai][m][bj], r);
#pragma unroll
                        for (int i = 0; i < 4; ++i) { r[i] += gv[bj][0][i] * acc[ai][bj][m][0][i]; r[4 + i] += gv[bj][1][i] * acc[ai][bj][m][1][i]; }
                        *(u32x4*)(rout + off + bj * 128) = pack8(r); } }
        }
    }
};

constexpr int NPH = 1 + 9 * DEPTH + 1;

__device__ __forceinline__ int opaque_gdim() { int g = (int)gridDim.x; asm volatile("" : "+s"(g)); return g; }
__global__ void __launch_bounds__(512, 2) fwd_kernel(Params p) {
    extern __shared__ __attribute__((aligned(16))) unsigned char lds_raw[];
    LASP unsigned char* lds = (LASP unsigned char*)lds_raw;
    int wv = __builtin_amdgcn_readfirstlane((int)(threadIdx.x >> 6)); asm volatile("" : "+s"(wv));
    const int tid = opaque_tid(wv);
    unsigned char* ws = p.ws;
#if ONE_LAUNCH
    constexpr int lo = 0, hi = NPH;
#else
    const int lo = p.ph_lo, hi = p.ph_hi;
#endif
    const bool multi = (hi - lo) > 1;
    XcdBarrier bar; bar.bar = (unsigned*)(ws + WS_CTL) + CW_BAR; bar.x = 0; bar.st = nullptr; bar.wv = wv;
    if (multi) {
        if (tid < 4) ((LASP unsigned*)(lds + LDS_BARW))[tid] = 0u;
        __syncthreads();
        bar = xcd_barrier_post((unsigned*)(ws + WS_CTL) + CW_BAR, (volatile LASP unsigned*)(lds + LDS_BARW), wv);
    }
#define IN(k) (lo <= (k) && (k) < hi)
#define SEAM(k) do { if ((k) + 1 < hi) { bar.x = xb_xcc_id(); xcd_barrier(bar); } } while (0)

    float* mod = (float*)(ws + WS_MOD);
    float* gates = (float*)(ws + WS_GATES);
    bf16* xc = (bf16*)(ws + WS_XC);
    bf16* xl = (bf16*)(ws + WS_XL);
    bf16* hbuf = (bf16*)(ws + WS_H);
    bf16* ubuf = (bf16*)(ws + WS_U);
#define split_ok (opaque_gdim() == 256)
    float* pbuf = (float*)(ws + WS_SO);
    bf16* so = (bf16*)(ws + WS_SO);
    unsigned char* wl = ws + WS_WT;
    const bf16* w_in = (const bf16*)wl; const bf16* w_out = (const bf16*)(wl + WT_IN_E);
    const bf16* w1 = (const bf16*)(wl + WT_IN_E + WT_OUT); const bf16* w2 = (const bf16*)(wl + WT_IN_E + WT_OUT + WT_W1);
    LASP float* tile = (LASP float*)lds;
#define CONVERT_LAYER(l_) do { const int e_ = (l_) >> 1; \
        if (((l_) & 1) == 0) { convert_wt(wv, pin(p, I_EWIN) + (size_t)e_ * D * EVEN_IN, D, EVEN_IN, EVEN_IN, (bf16*)wl, EV_PAD, 1, tile); \
                               convert_wt(wv, pin(p, I_EWOUT) + (size_t)e_ * D * D, D, D, D, (bf16*)(wl + WT_IN_E), D, 0, tile); } \
        else { convert_wt(wv, pin(p, I_OWIN) + (size_t)e_ * D * ODD_IN, D, ODD_IN, ODD_IN, (bf16*)wl, OD_PAD, 0, tile); \
               convert_wt(wv, pin(p, I_OWOUT) + (size_t)e_ * D * D, D, D, D, (bf16*)(wl + WT_IN_E), D, 0, tile); } \
        convert_wt(wv, pin(p, I_W1) + (size_t)(l_) * D * DFF, D, DFF, DFF, (bf16*)(wl + WT_IN_E + WT_OUT), DFF, 0, tile); \
        convert_wt(wv, pin(p, I_W2) + (size_t)(l_) * DFF * D, DFF, D, D, (bf16*)(wl + WT_IN_E + WT_OUT + WT_W1), D, 0, tile); } while (0)

    if (IN(0)) {
        CONVERT_LAYER(0);
        __syncthreads();
        phase_mod(wv, p, lds);
        SEAM(0);
    }

    for (int l = 0; l < DEPTH; ++l) {
        const int pb = 1 + 9 * l, e = l >> 1;
        const bool odd = (l & 1) != 0, last = (l == DEPTH - 1), first = (l == 0);
        const float* modl = mod + (size_t)l * 17 * MODW;
        const void* xc_cur = first ? (const void*)pin(p, I_CTX) : (const void*)xc;
        const void* xl_cur = first ? (const void*)pin(p, I_X) : (const void*)xl;
        const int ldu = odd ? OD_MAIN : EV_MAIN;
        const int row_lo2 = last ? TC : 0;

        if (IN(pb + 0)) {
            phase_norm(wv, xc_cur, xl_cur, first, pin(p, I_NORMW) + (size_t)(l * 2 + 0) * D, modl, 1, 0, hbuf, 0, (!first && split_ok) ? pbuf : (const float*)nullptr, xc, lds);
            if (!first) CONVERT_LAYER(l);
            SEAM(pb + 0);
        }
        if (IN(pb + 1)) {
            const int npad = odd ? OD_PAD : EV_PAD;
            pg8::Gemm g{hbuf, w_in, T, npad, D}; pg8::InOrder S; S.init(npad, D, gridDim.x, blockIdx.x, 4, OU_O / 256, last ? (OU_O + 2048) / 256 : OU_O / 256);
            EpiU E{ubuf, ldu, (odd ? OD_MAIN : EV_MAIN) / 256, gates,
                   odd ? pin(p, I_MCONVW) + (size_t)e * 3 * 2048 : pin(p, I_SCONVW) + (size_t)e * 3 * 1536, odd ? pin(p, I_MCONVB) + (size_t)e * 2048 : pin(p, I_SCONVB) + (size_t)e * 1536,
                   odd ? 0 : EU_XBC / 256, odd ? 8 : (EU_XBC + 1536) / 256, odd ? 2048 : 1536, odd ? 4 : 1000, lds};
            pg8::gemm_phase<EpiU, pg8::InOrder, true, true>(wv, lds, g, S, E);
            SEAM(pb + 1);
        }
        if (IN(pb + 3)) {
            if (!odd) {
                phase_ssd_chunk(wv, ubuf, gates, pin(p, I_ALOG) + e * 32, pin(p, I_DTB) + e * 32, so, lds); __syncthreads();
                phase_hgrn_chunk(wv, ubuf, pin(p, I_HLB), e, so, lds);
            } else {
                phase_mlstm_chunk(wv, ubuf, gates, pin(p, I_MGATEB) + e * 16, so, lds);
            }
            SEAM(pb + 3);
        }
        if (IN(pb + 4)) {
            if (!odd) phase_out_even(wv, ubuf, so, pin(p, I_SSDD) + e * 16, pin(p, I_SSDNW) + e * 1024, pin(p, I_HNW) + e * 1024, hbuf, row_lo2);
            else phase_out_odd(wv, ubuf, so, pin(p, I_MNW) + (size_t)e * D, hbuf, row_lo2);
            SEAM(pb + 4);
        }
        if (IN(pb + 5)) {
            const int M = T - row_lo2;
            pg8::Gemm g{hbuf, w_out, M, D, D}; pg8::ResOrder S; S.init(D, D, gridDim.x, blockIdx.x, last ? 0 : 1, 4);
            EpiRes E{xc_cur, xc, xl_cur, xl, first ? 1 : 0, modl + 2 * D, 0, pbuf};
            pg8::gemm_phase<EpiRes, pg8::ResOrder, true, true>(wv, lds, g, S, E);
            SEAM(pb + 5);
        }
        if (IN(pb + 6)) { phase_norm(wv, xc, xl, false, pin(p, I_NORMW) + (size_t)(l * 2 + 1) * D, modl, 4, 3, hbuf, row_lo2, (last || !split_ok) ? (const float*)nullptr : pbuf, xc, lds); SEAM(pb + 6); }
        if (IN(pb + 7)) {
            const int M = T - row_lo2;
            pg8::Gemm g{hbuf + (size_t)row_lo2 * D, w1, M, DFF, D}; pg8::StaticOrder S; S.init(M, DFF, D, gridDim.x, blockIdx.x, 4);
            EpiAct E{ubuf + (size_t)row_lo2 * DFF, DFF};
            pg8::gemm_phase<EpiAct, pg8::StaticOrder, true, true>(wv, lds, g, S, E);
            SEAM(pb + 7);
        }
        if (IN(pb + 8)) {
            const int M = T - row_lo2;
            pg8::Gemm g{ubuf, w2, M, D, DFF}; pg8::ResOrder S; S.init(D, DFF, gridDim.x, blockIdx.x, last ? 0 : 1, 4);
            EpiRes E{xc, xc, xl, xl, 0, modl + 5 * D, 0, pbuf};
            pg8::gemm_phase<EpiRes, pg8::ResOrder, true, true>(wv, lds, g, S, E);
            SEAM(pb + 8);
        }
    }
#undef CONVERT_LAYER
    if (IN(NPH - 1)) phase_final_norm(wv, xl, p.out, pin(p, I_FNORMW));
#undef IN
#undef SEAM
}

extern "C" void kernel_launch(void* const* d_in, const int* in_sizes, int n_in, void* d_out, int out_size, void* d_ws, size_t ws_size, hipStream_t stream) {
    static int grid = 0;
    if (grid == 0) {
        if (n_in != 26 || out_size != TL * D || ws_size < WS_END) { fprintf(stderr, "kernel_launch: unexpected shapes (n_in %d out %d ws %zu need %zu)\n", n_in, out_size, ws_size, (size_t)WS_END); grid = -1; return; }
        int dev = 0, cus = 0;
        if (hipGetDevice(&dev) != hipSuccess || hipDeviceGetAttribute(&cus, hipDeviceAttributeMultiprocessorCount, dev) != hipSuccess) { grid = -1; return; }
        if (hipFuncSetAttribute((const void*)fwd_kernel, hipFuncAttributeMaxDynamicSharedMemorySize, LDS_BYTES) != hipSuccess) { fprintf(stderr, "kernel_launch: hipFuncSetAttribute failed\n"); grid = -1; return; }
        int per_cu = 0;
        if (hipOccupancyMaxActiveBlocksPerMultiprocessor(&per_cu, (const void*)fwd_kernel, 512, LDS_BYTES) != hipSuccess || per_cu < 1) { fprintf(stderr, "kernel_launch: occupancy query says %d\n", per_cu); }
        (void)hipGetLastError();
        grid = cus;
    }
    if (grid < 0) return;
    (void)hipMemsetAsync((char*)d_ws + WS_CTL, 0, CTL_BYTES, stream);
    Params p{};
    for (int i = 0; i < 26; ++i) p.in[i] = (const float*)d_in[i];
    p.out = (float*)d_out; p.ws = (unsigned char*)d_ws;
#if ONE_LAUNCH
    p.ph_lo = 0; p.ph_hi = NPH;
    hipLaunchKernelGGL(fwd_kernel, dim3(grid), dim3(512), LDS_BYTES, stream, p);
#else
    for (int k = 0; k < NPH; ++k) { p.ph_lo = k; p.ph_hi = k + 1; hipLaunchKernelGGL(fwd_kernel, dim3(grid), dim3(512), LDS_BYTES, stream, p); }
#endif
}
```

```cpp
#include <hip/hip_runtime.h>
#include <cstdio>
#include <cstdint>
#ifndef ONE_LAUNCH
#define ONE_LAUNCH 0
#endif
#undef ONE_LAUNCH
#define ONE_LAUNCH 1
__device__ __forceinline__ int opaque_tid(int wv) { unsigned z = 0u; asm volatile("" : "+v"(z)); const int l = (int)__builtin_amdgcn_mbcnt_hi(~0u, __builtin_amdgcn_mbcnt_lo(~0u, z)); return (wv << 6) | l; }
namespace pg8 {
#define PG8_LAS __attribute__((address_space(3)))
typedef unsigned short bf16_t;
typedef short bf16x8 __attribute__((ext_vector_type(8)));
typedef float f32x4 __attribute__((ext_vector_type(4)));
typedef unsigned u32x4 __attribute__((ext_vector_type(4)));
constexpr int BM = 256, BK = 64, HALF = 128, HTB = HALF * BK * 2  , STAGE_BYTES = 8 * HTB, NXCD = 8, WGM = 8;

__host__ __device__ __forceinline__ int lds_byte(int r, int c) { const int st = (r >> 4) * 2 + (c >> 5), rr = r & 15, cc = c & 31, ob = rr * 64 + cc * 2; return st * 1024 + (ob ^ (((ob >> 9) & 1) << 5)); }
__host__ __device__ __forceinline__ void stage_rc(int b, int& R, int& C) { const int st = b / 1024, sb = b % 1024, swz = sb ^ (((sb >> 9) & 1) << 5); R = (st >> 1) * 16 + swz / 64; C = (st & 1) * 32 + (swz % 64) / 2; }
__host__ __device__ __forceinline__ int perm32(int rho) { const int n = rho >> 4, i = rho & 15; return 8 * (i >> 2) + 4 * n + (i & 3); }

__host__ __device__ __forceinline__ int perm32_inv(int cidx) { return ((cidx >> 2) & 1) * 16 + ((cidx >> 3) << 2) + (cidx & 3); }
__host__ __device__ __forceinline__ size_t tiled_off(size_t row, int col, int K, bool perm = false) {
    int r = (int)(row & 127); if (perm) r = (r & ~31) + perm32_inv(r & 31);
    return ((row >> 8) * (size_t)(K / BK) + (size_t)(col >> 6)) * (size_t)(BM * BK) + ((row >> 7) & 1) * (size_t)(HALF * BK) + (size_t)(lds_byte(r, col & 63) >> 1);
}
struct Unit { int pm, pn, kt0, nkt, part; };
struct Gemm { const bf16_t* A; const bf16_t* Bt; int M, N, K; };

struct StaticOrder {
    int nM, nN, nwg, G, c, nkt, wgm;
    __host__ __device__ void init(int M, int N, int K, int G_, int c_, int wgm_ = WGM) { nM = M / BM; nN = N / BM; nwg = nM * nN; G = G_; c = c_; nkt = K / BK; wgm = wgm_; }
    __host__ __device__ bool next(int i, Unit& u) const {
        const long L = (long)i * G + c; if (L >= nwg) return false;
        u.kt0 = 0; u.nkt = nkt; u.part = 0;
        int wgid = (int)L; { const int q = nwg / NXCD, r = nwg % NXCD, xcd = wgid % NXCD, off = wgid / NXCD; wgid = (xcd < r ? xcd * (q + 1) : r * (q + 1) + (xcd - r) * q) + off; }
        const int nig = wgm * nN, gid = wgid / nig, fm = gid * wgm, gsz = (nM - fm) < wgm ? (nM - fm) : wgm;
        u.pm = fm + ((wgid % nig) % gsz); u.pn = (wgid % nig) / gsz; return true;
    }
    __device__ __forceinline__ void a_ready(const Unit&) const {}
    __device__ __forceinline__ void done(const Unit&) const {}
};

struct ResOrder {
    StaticOrder lat; int ctx, nkt, c, G;
    __host__ __device__ void init(int N, int K, int G_, int c_, int with_ctx, int wgm_ = WGM) { lat.init(32768, N, K, G_, c_, wgm_); ctx = with_ctx; nkt = K / BK; c = c_; G = G_; }
    __host__ __device__ bool next(int i, Unit& u) const {
        if (lat.next(i, u)) { u.pm += 16; return true; }
        if (!ctx) return false;
        const int r0 = (lat.nwg + G - 1) / G;
        if (G == 256) {
            if (i != r0) return false;
            const int j = c & 127; u.pm = j & 15; u.pn = j >> 4; u.part = 1 + (c >> 7); u.nkt = nkt / 2; u.kt0 = (c >> 7) * (nkt / 2); return true;
        }
        const long j = (long)(i - r0) * G + c; if (i < r0 || j >= 128) return false;
        u.pm = (int)(j & 15); u.pn = (int)(j >> 4); u.part = 0; u.nkt = nkt; u.kt0 = 0; return true;
    }
    __device__ __forceinline__ void a_ready(const Unit&) const {}
    __device__ __forceinline__ void done(const Unit&) const {}
};

struct InOrder {
    StaticOrder lat; int nN, G, c, nkt, skip_lo, skip_n;
    __host__ __device__ void init(int N, int K, int G_, int c_, int wgm_, int skip_lo_, int skip_hi_) { lat.init(32768, N, K, G_, c_, wgm_); nN = N / BM; G = G_; c = c_; nkt = K / BK; skip_lo = skip_lo_; skip_n = skip_hi_ - skip_lo_; }
    __host__ __device__ bool next(int i, Unit& u) const {
        if (lat.next(i, u)) { u.pm += 16; return true; }
        const long j = (long)i * G + c - lat.nwg; if (j < 0 || j >= 16L * (nN - skip_n)) return false;
        const int q = (int)(j >> 4); u.pm = (int)(j & 15); u.pn = q < skip_lo ? q : q + skip_n; u.kt0 = 0; u.nkt = nkt; u.part = 0; return true;
    }
    __device__ __forceinline__ void a_ready(const Unit&) const {}
    __device__ __forceinline__ void done(const Unit&) const {}
};

typedef __bf16 nbf16x2 __attribute__((ext_vector_type(2))); typedef float nf32x2 __attribute__((ext_vector_type(2)));
__device__ __forceinline__ unsigned cvt_pk_bf16(float lo, float hi) { const nf32x2 f = {lo, hi}; return __builtin_bit_cast(unsigned, __builtin_convertvector(f, nbf16x2)); }
typedef float f32x2 __attribute__((ext_vector_type(2)));
template <class Epi, class Sched, bool ALIGN_EPI = false, bool SP2 = false>
__device__ __forceinline__ void gemm_phase(int wv, PG8_LAS unsigned char* lds, const Gemm g, const Sched& S, const Epi& E) {
    const int tid = opaque_tid(wv), wid = __builtin_amdgcn_readfirstlane(tid >> 6), lane = tid & 63, wr = wid >> 2, wc = wid & 3, fr = lane & 15, fq = lane >> 4;
    const int K = g.K;
    unsigned voffA[2], voffB[2];
#pragma unroll
    for (int i = 0; i < 2; ++i) { voffA[i] = (unsigned)(tid * 16 + i * 8192); voffB[i] = voffA[i]; }
    const size_t kstep = (size_t)(BM * BK * 2);
    const size_t hstep = (size_t)HALF * BK * 2;
    const size_t tstep = (size_t)(K / BK) * kstep;
    const unsigned ldsw = (unsigned)wid * 1024u;
    const int aoff = lds_byte(wr * 64 + fr, fq * 8), boff = lds_byte(wc * 32 + fr, fq * 8);
#define PG8_SA(b, h) (((b) * 2 + (h)) * HTB)
#define PG8_SB(b, h) ((4 + (b) * 2 + (h)) * HTB)
#define PG8_STAGE(bufoff, gbase, voff) do { _Pragma("unroll") for (int _i = 0; _i < 2; ++_i) \
        __builtin_amdgcn_global_load_lds((const unsigned*)((const char*)(gbase) + (voff)[_i]), (PG8_LAS unsigned*)(lds + (bufoff) + ldsw + _i * 8192), 16, 0, 0); } while (0)
#define PG8_LDA(dst, b, h) do { _Pragma("unroll") for (int m = 0; m < 4; ++m) _Pragma("unroll") for (int k = 0; k < 2; ++k) dst[m][k] = *(const PG8_LAS bf16x8*)(lds + PG8_SA(b, h) + aoff + m * 2048 + k * 1024); } while (0)
#define PG8_LDB(dst, b, h) do { _Pragma("unroll") for (int n = 0; n < 2; ++n) _Pragma("unroll") for (int k = 0; k < 2; ++k) dst[n][k] = *(const PG8_LAS bf16x8*)(lds + PG8_SB(b, h) + boff + n * 2048 + k * 1024); } while (0)
#define PG8_MMA(ai, bj, At, Bt) do { __builtin_amdgcn_s_setprio(1); _Pragma("unroll") for (int m = 0; m < 4; ++m) _Pragma("unroll") for (int n = 0; n < 2; ++n) _Pragma("unroll") for (int k = 0; k < 2; ++k) \
        acc[ai][bj][m][n] = __builtin_amdgcn_mfma_f32_16x16x32_bf16(Bt[n][k], At[m][k], acc[ai][bj][m][n], 0, 0, 0); __builtin_amdgcn_s_setprio(0); } while (0)
#define PG8_WAIT_V(n) asm volatile("s_waitcnt vmcnt(" #n ")" ::: "memory")
#define PG8_WAIT_L(n) asm volatile("s_waitcnt lgkmcnt(" #n ")" ::: "memory")
#define PG8_BAR __builtin_amdgcn_s_barrier()
#define PG8_SCHED __builtin_amdgcn_sched_barrier(0)
    Unit cur, nxt; int ui = 0;
    if (!S.next(0, cur)) return;
    f32x4 acc[2][2][4][2];
#pragma unroll
    for (int a = 0; a < 2; ++a)
#pragma unroll
        for (int b = 0; b < 2; ++b)
#pragma unroll
            for (int m = 0; m < 4; ++m)
#pragma unroll
                for (int n = 0; n < 2; ++n) acc[a][b][m][n] = (f32x4){0.f, 0.f, 0.f, 0.f};
    bf16x8 At[4][2], B0[2][2], B1[2][2];
    const char* cA = (const char*)g.A + (size_t)cur.pm * tstep + (size_t)cur.kt0 * kstep; const char* cB = (const char*)g.Bt + (size_t)cur.pn * tstep + (size_t)cur.kt0 * kstep;
    S.a_ready(cur);
    if constexpr (SP2) {
        PG8_STAGE(PG8_SB(0, 0), cB, voffB); PG8_STAGE(PG8_SB(0, 1), cB + hstep, voffB); PG8_STAGE(PG8_SA(0, 0), cA, voffA); PG8_STAGE(PG8_SA(0, 1), cA + hstep, voffA);
        if (wr == 1) PG8_BAR;
        PG8_WAIT_V(2); PG8_BAR;
        PG8_STAGE(PG8_SB(1, 0), cB + kstep, voffB); PG8_STAGE(PG8_SA(1, 0), cA + kstep, voffA); PG8_STAGE(PG8_SB(1, 1), cB + hstep + kstep, voffB);
        PG8_WAIT_V(6); PG8_BAR;
    } else {
        PG8_STAGE(PG8_SB(0, 0), cB, voffB); PG8_STAGE(PG8_SA(0, 0), cA, voffA); PG8_STAGE(PG8_SB(0, 1), cB + hstep, voffB); PG8_STAGE(PG8_SA(0, 1), cA + hstep, voffA);
        if (wr == 1) PG8_BAR;
        PG8_WAIT_V(4); PG8_BAR;
        PG8_STAGE(PG8_SB(1, 0), cB + kstep, voffB); PG8_STAGE(PG8_SA(1, 0), cA + kstep, voffA); PG8_STAGE(PG8_SB(1, 1), cB + hstep + kstep, voffB);
        PG8_WAIT_V(6); PG8_BAR;
    }
    for (;;) {
        const bool has_next = S.next(ui + 1, nxt);
        const char* nA = has_next ? (const char*)g.A + (size_t)nxt.pm * tstep + (size_t)nxt.kt0 * kstep : cA; const char* nB = has_next ? (const char*)g.Bt + (size_t)nxt.pn * tstep + (size_t)nxt.kt0 * kstep : cB;
        const int nt = cur.nkt;
        int t = 0;
        asm volatile(".p2align 6" ::: "memory");
        do {
            const bool last = (t == nt - 2);
            const char* a1 = cA + (size_t)(t + 1) * kstep;
            const char* a2 = last ? nA : cA + (size_t)(t + 2) * kstep; const char* b2 = last ? nB : cB + (size_t)(t + 2) * kstep;
            const char* a3 = a2 + kstep; const char* b3 = b2 + kstep;
            if (last && has_next) S.a_ready(nxt);
            if constexpr (SP2) {
            PG8_LDB(B0, 0, 0); PG8_LDB(B1, 0, 1); PG8_SCHED; PG8_LDA(At, 0, 0); PG8_STAGE(PG8_SA(1, 1), a1 + hstep, voffA);
            PG8_WAIT_V(8); PG8_WAIT_L(0); PG8_BAR; PG8_MMA(0, 0, At, B0); PG8_MMA(0, 1, At, B1); PG8_BAR; PG8_SCHED;
            PG8_LDA(At, 0, 1); PG8_STAGE(PG8_SB(0, 0), b2, voffB); PG8_STAGE(PG8_SB(0, 1), b2 + hstep, voffB); PG8_STAGE(PG8_SA(0, 0), a2, voffA);
            PG8_WAIT_V(8); PG8_WAIT_L(0); PG8_BAR; PG8_MMA(1, 0, At, B0); PG8_MMA(1, 1, At, B1); PG8_BAR; PG8_SCHED;
            PG8_LDB(B0, 1, 0); PG8_LDB(B1, 1, 1); PG8_SCHED; PG8_LDA(At, 1, 0); PG8_STAGE(PG8_SA(0, 1), a2 + hstep, voffA);
            PG8_WAIT_V(8); PG8_WAIT_L(0); PG8_BAR; PG8_MMA(0, 0, At, B0); PG8_MMA(0, 1, At, B1); PG8_BAR; PG8_SCHED;
            PG8_LDA(At, 1, 1); PG8_STAGE(PG8_SB(1, 0), b3, voffB); PG8_STAGE(PG8_SB(1, 1), b3 + hstep, voffB); PG8_STAGE(PG8_SA(1, 0), a3, voffA);
            PG8_WAIT_V(8); PG8_WAIT_L(0); PG8_BAR; PG8_MMA(1, 0, At, B0); PG8_MMA(1, 1, At, B1); PG8_BAR; PG8_SCHED;
            } else {
            PG8_LDB(B0, 0, 0); PG8_SCHED; PG8_LDA(At, 0, 0); PG8_STAGE(PG8_SA(1, 1), a1 + hstep, voffA);
            PG8_WAIT_L(8); PG8_BAR; PG8_WAIT_L(0); PG8_MMA(0, 0, At, B0); PG8_BAR; PG8_SCHED;
            PG8_LDB(B1, 0, 1); PG8_STAGE(PG8_SB(0, 0), b2, voffB);
            PG8_BAR; PG8_WAIT_L(0); PG8_MMA(0, 1, At, B1); PG8_BAR;
            PG8_LDA(At, 0, 1); PG8_STAGE(PG8_SA(0, 0), a2, voffA);
            PG8_BAR; PG8_WAIT_L(0); PG8_MMA(1, 0, At, B0); PG8_BAR; PG8_SCHED;
            PG8_STAGE(PG8_SB(0, 1), b2 + hstep, voffB);
            PG8_WAIT_V(6); PG8_BAR; PG8_MMA(1, 1, At, B1); PG8_BAR;
            PG8_LDB(B0, 1, 0); PG8_SCHED; PG8_LDA(At, 1, 0); PG8_STAGE(PG8_SA(0, 1), a2 + hstep, voffA);
            PG8_WAIT_L(8); PG8_BAR; PG8_WAIT_L(0); PG8_MMA(0, 0, At, B0); PG8_BAR; PG8_SCHED;
            PG8_LDB(B1, 1, 1); PG8_STAGE(PG8_SB(1, 0), b3, voffB);
            PG8_BAR; PG8_WAIT_L(0); PG8_MMA(0, 1, At, B1); PG8_BAR;
            PG8_LDA(At, 1, 1); PG8_STAGE(PG8_SA(1, 0), a3, voffA);
            PG8_BAR; PG8_WAIT_L(0); PG8_MMA(1, 0, At, B0); PG8_BAR; PG8_SCHED;
            PG8_STAGE(PG8_SB(1, 1), b3 + hstep, voffB);
            PG8_WAIT_V(6); PG8_BAR; PG8_MMA(1, 1, At, B1); PG8_BAR;
            }
            t += 2;
        } while (t < nt);
        if constexpr (ALIGN_EPI) { if (wr == 0) PG8_BAR; }
        if constexpr (!Epi::AFTER_DRAIN) { E(acc, cur, wr, wc, fr, fq); S.done(cur); }
        if (!has_next) break;
#pragma unroll
        for (int a = 0; a < 2; ++a)
#pragma unroll
            for (int b = 0; b < 2; ++b)
#pragma unroll
                for (int m = 0; m < 4; ++m)
#pragma unroll
                    for (int n = 0; n < 2; ++n) acc[a][b][m][n] = (f32x4){0.f, 0.f, 0.f, 0.f};
        cur = nxt; cA = nA; cB = nB; ++ui;
        if constexpr (ALIGN_EPI) { if (wr == 1) PG8_BAR; }
    }
    PG8_WAIT_V(0);
    if constexpr (!ALIGN_EPI) { if (wr == 0) PG8_BAR; }
    PG8_BAR;
    if constexpr (Epi::AFTER_DRAIN) { E.fused(acc, cur, wr, wc, fr, fq, lds, wid, lane); S.done(cur); }
#undef PG8_SA
#undef PG8_SB
#undef PG8_STAGE
#undef PG8_LDA
#undef PG8_LDB
#undef PG8_MMA
#undef PG8_WAIT_V
#undef PG8_WAIT_L
#undef PG8_BAR
#undef PG8_SCHED
}
}

#define XB_TMO      128
#define XB_XCNT(j)  (256  + 64 * (j))
#define XB_XSUB(j)  (1280 + 64 * (j))
#define XB_XGEN(j)  (2304 + 64 * (j))
#define XB_TOP      3328
#define XB_TOPGEN   3392
#define XCD_BAR_WORDS 3456
#define XB_SPIN_CAP (1u << 18)
#define LAS __attribute__((address_space(3)))

__device__ __forceinline__ unsigned xb_ld(unsigned* p)              { return __hip_atomic_load(p, __ATOMIC_RELAXED, __HIP_MEMORY_SCOPE_AGENT); }
__device__ __forceinline__ unsigned xb_add(unsigned* p, unsigned v) { return __hip_atomic_fetch_add(p, v, __ATOMIC_RELAXED, __HIP_MEMORY_SCOPE_AGENT); }
__device__ __forceinline__ unsigned xb_xcc_id() { return (unsigned)__builtin_amdgcn_s_getreg((3 << 11) | 20) & 0xFu; }
#define XB_SPIN(cond, bar) do { unsigned _sp = 0; while (cond) { __builtin_amdgcn_s_sleep(1); \
    if ((++_sp & 255u) == 0u) { if (xb_ld(&(bar)[XB_TMO])) break; if (_sp > XB_SPIN_CAP) { atomicAdd(&(bar)[XB_TMO], 1u); break; } } } } while (0)

struct XcdBarrier {
    unsigned* bar; unsigned x; int wv;
    volatile LAS unsigned* st;
};

__device__ __forceinline__ XcdBarrier xcd_barrier_post(unsigned* bar, volatile LAS unsigned* st, int wv) {
    XcdBarrier b; b.bar = bar; b.x = xb_xcc_id(); b.st = st; b.wv = wv;
    if (opaque_tid(wv) == 0) (void)xb_add(&bar[XB_XCNT(b.x)], 1u);
    return b;
}
__device__ __forceinline__ void xcd_barrier_complete(unsigned* bar, unsigned x, unsigned& nloc, unsigned& nx) {
    const unsigned G = gridDim.x * gridDim.y * gridDim.z;
    unsigned sum, cnt, mine, sp = 0u;
    for (;;) {
        sum = 0u; cnt = 0u; mine = 0u;
#pragma unroll
        for (unsigned j = 0; j < 16; ++j) { const unsigned c = xb_ld(&bar[XB_XCNT(j)]); sum += c; cnt += (c > 0u) ? 1u : 0u; mine = (j == x) ? c : mine; }
        if (sum == G) break;
        __builtin_amdgcn_s_sleep(1);
        if ((++sp & 255u) == 0u) { if (xb_ld(&bar[XB_TMO])) break; if (sp > XB_SPIN_CAP) { atomicAdd(&bar[XB_TMO], 1u); break; } }
    }
    nloc = mine > 0u ? mine : 1u; nx = cnt > 0u ? cnt : 1u;
}

__device__ __forceinline__ void xcd_barrier(const XcdBarrier& b) {
    asm volatile("s_waitcnt vmcnt(0)" ::: "memory");
    __syncthreads();
    if (opaque_tid(b.wv) == 0) {
        unsigned* bar = b.bar;
        __builtin_amdgcn_s_waitcnt(0);
        unsigned nloc = b.st[0], nx = b.st[1];
        if (nloc == 0u) { xcd_barrier_complete(bar, b.x, nloc, nx); b.st[0] = nloc; b.st[1] = nx; }
        const unsigned old = xb_add(&bar[XB_XSUB(b.x)], 1u);
        const unsigned gen = old / nloc;
        if (old + 1u == (gen + 1u) * nloc) {
            __builtin_amdgcn_fence(__ATOMIC_RELEASE, "agent");
            asm volatile("s_waitcnt vmcnt(0)" ::: "memory");
            const unsigned og = xb_add(&bar[XB_TOP], 1u);
            const unsigned tg = og / nx;
            if (og + 1u == (tg + 1u) * nx) xb_add(&bar[XB_TOPGEN], 1u);
            else XB_SPIN(xb_ld(&bar[XB_TOPGEN]) == tg, bar);
            __builtin_amdgcn_fence(__ATOMIC_ACQUIRE, "agent");
            xb_add(&bar[XB_XGEN(b.x)], 1u);
            asm volatile("s_waitcnt vmcnt(0)" ::: "memory");
        } else {
            XB_SPIN(xb_ld(&bar[XB_XGEN(b.x)]) == gen, bar);
            __builtin_amdgcn_fence(__ATOMIC_ACQUIRE, "agent");
            asm volatile("s_waitcnt vmcnt(0)" ::: "memory");
        }
    }
    __syncthreads();
}


#define LASP __attribute__((address_space(3)))
typedef unsigned short bf16;
typedef pg8::f32x4 f32x4;
typedef pg8::u32x4 u32x4;
typedef unsigned u32x2 __attribute__((ext_vector_type(2)));
typedef float f32x2 __attribute__((ext_vector_type(2)));
constexpr int D = 2048, BATCH = 16, SEQ = 2048, CTX = 256, DEPTH = 4, DFF = 8192;
constexpr int TC = BATCH * CTX, TL = BATCH * SEQ, T = TC + TL;
constexpr int MODW = 6 * D;
constexpr int EVEN_IN = 7712, ODD_IN = 6160;
constexpr int EV_MAIN = 7680, EV_PAD = 7936, OD_MAIN = 6144, OD_PAD = 6400;
constexpr int EU_Z = 0, EU_XBC = 1024, EU_Q = 2560, EU_F = 3584, EU_I = 5632, EU_G = 6656;
constexpr int OU_QK = 0, OU_V = 2048, OU_O = 4096;
constexpr float EPS = 1e-6f;

constexpr size_t MiB = 1u << 20;
constexpr size_t WS_CTL = 0, CTL_BYTES = 64 * 1024;
constexpr size_t WS_MOD = 1 * MiB;
constexpr size_t WS_GATES = 5 * MiB;
constexpr size_t WS_XC = 10 * MiB;
constexpr size_t WS_XL = 42 * MiB;
constexpr size_t WS_WT = 170 * MiB;
constexpr size_t WT_IN_E = (size_t)EV_PAD * D * 2, WT_IN_O = (size_t)OD_PAD * D * 2, WT_OUT = (size_t)D * D * 2, WT_W1 = (size_t)DFF * D * 2, WT_W2 = (size_t)D * DFF * 2;
constexpr size_t WT_LAYER = 104 * MiB;
constexpr size_t WS_H = WS_WT + WT_LAYER;
constexpr size_t WS_U = WS_H + (size_t)T * D * 2;
constexpr size_t WS_SO = WS_U + (size_t)T * DFF * 2;
constexpr size_t WS_END = WS_SO + (size_t)T * D * 4;
static_assert(WT_IN_E + WT_OUT + WT_W1 + WT_W2 <= WT_LAYER, "weights per layer");
static_assert(WS_END <= (size_t)1536 * MiB && WS_XL + (size_t)TL * D * 2 <= WS_WT, "workspace");
constexpr int CW_BAR = 4096;

constexpr int LDS_BYTES = 147456;
constexpr int LDS_BARW = LDS_BYTES - 64;

struct Params { const float* in[26]; float* out; unsigned char* ws; int ph_lo, ph_hi; };
enum { I_X = 0, I_C, I_CTX, I_CCTX, I_MODW, I_MODB, I_NORMW, I_FNORMW, I_W1, I_W2, I_EWIN, I_EWOUT, I_SCONVW, I_SCONVB, I_ALOG, I_DTB, I_SSDD, I_SSDNW, I_HLB, I_HNW, I_OWIN, I_OWOUT, I_MCONVW, I_MCONVB, I_MGATEB, I_MNW };

__device__ __forceinline__ const float* pin(const Params& p, int i) { asm volatile("" : "+s"(i)); return p.in[i]; }
__device__ __forceinline__ float bf2f(bf16 h) { return __uint_as_float((unsigned)h << 16); }
__device__ __forceinline__ float bf_lo(unsigned w) { return __uint_as_float(w << 16); }
__device__ __forceinline__ float bf_hi(unsigned w) { return __uint_as_float(w & 0xffff0000u); }
__device__ __forceinline__ void unpack8(const u32x4 w, float (&f)[8]) { f[0] = bf_lo(w.x); f[1] = bf_hi(w.x); f[2] = bf_lo(w.y); f[3] = bf_hi(w.y); f[4] = bf_lo(w.z); f[5] = bf_hi(w.z); f[6] = bf_lo(w.w); f[7] = bf_hi(w.w); }
__device__ __forceinline__ u32x4 pack8(const float (&f)[8]) { u32x4 w; w.x = pg8::cvt_pk_bf16(f[0], f[1]); w.y = pg8::cvt_pk_bf16(f[2], f[3]); w.z = pg8::cvt_pk_bf16(f[4], f[5]); w.w = pg8::cvt_pk_bf16(f[6], f[7]); return w; }
__device__ __forceinline__ float sigmoid_(float x) { return 1.f / (1.f + __expf(-x)); }
__device__ __forceinline__ float silu_(float x) { return x / (1.f + __expf(-x)); }
__device__ __forceinline__ float log1p_pos(float y) { return y < 0.0078125f ? y * (1.f - y * (0.5f - y * 0.33333334f)) : __logf(1.f + y); }
__device__ __forceinline__ float softplus_(float x) { return x > 20.f ? x : log1p_pos(__expf(x)); }
__device__ __forceinline__ float shx(float v, int m, int lane) { return __int_as_float(__builtin_amdgcn_ds_bpermute((lane ^ m) << 2, __float_as_int(v))); }
__device__ __forceinline__ float shup(float v, int o, int lane) { return __int_as_float(__builtin_amdgcn_ds_bpermute((lane - o) << 2, __float_as_int(v))); }
__device__ __forceinline__ float rdlane(float v, int l) { return __int_as_float(__builtin_amdgcn_readlane(__float_as_int(v), l)); }
__device__ __forceinline__ float wave_sum(float v, int lane) {
#pragma unroll
    for (int o = 32; o > 0; o >>= 1) v += shx(v, o, lane);
    return v;
}
__device__ __forceinline__ int seq_row(int b, int dir, int s) {
    if (s < CTX) return b * CTX + (dir ? (CTX - 1 - s) : s);
    const int j = s - CTX; return TC + b * SEQ + (dir ? (SEQ - 1 - j) : j);
}

__device__ __forceinline__ int chunk_row0(int b, int dir, int c) {
    if (c < CTX / 64) return b * CTX + (dir ? CTX - 64 - c * 64 : c * 64);
    const int j0 = (c - CTX / 64) * 64; return TC + b * SEQ + (dir ? SEQ - 64 - j0 : j0);
}
__device__ __forceinline__ int rix(int dir, int s) { return dir ? 63 - s : s; }

__device__ __forceinline__ int wt_map(int n, int mode, int Nsrc) {
    if (mode == 0) return n < Nsrc ? n : -1;
    if (n < 2560) return n;
    if (n < EV_MAIN) return n + 32;
    if (n < EV_MAIN + 32) return 2560 + (n - EV_MAIN);
    return -1;
}
__device__ __forceinline__ void convert_wt(int wv, const float* src, int K, int ldsrc, int Nsrc, bf16* dst, int Npad, int mode, LASP float* tile) {
    const int tid = opaque_tid(wv), nkt = K / 64, nnt = Npad / 64, ntiles = nkt * nnt;
    for (int it0 = blockIdx.x; it0 < ntiles; it0 += 4 * gridDim.x) {
        f32x4 v[4][2];
#pragma unroll
        for (int q = 0; q < 4; ++q) { const int it = it0 + q * gridDim.x; const bool live = it < ntiles; const int itc = live ? it : it0;
            const int ntl = itc % nnt, kt = itc / nnt, k0 = kt * 64, n0 = ntl * 64;
#pragma unroll
            for (int i = 0; i < 2; ++i) { const int e = tid + i * 512, kk = e >> 4, n4 = (e & 15) * 4, sc = wt_map(n0 + n4, mode, Nsrc);
                v[q][i] = (f32x4){0.f, 0.f, 0.f, 0.f};
                if (sc >= 0) v[q][i] = *(const f32x4*)(src + (size_t)(k0 + kk) * ldsrc + sc); } }
#pragma unroll
        for (int q = 0; q < 4; ++q) { LASP float* tl = tile + q * (64 * 65);
#pragma unroll
            for (int i = 0; i < 2; ++i) { const int e = tid + i * 512, kk = e >> 4, n4 = (e & 15) * 4;
                tl[kk * 65 + n4 + 0] = v[q][i][0]; tl[kk * 65 + n4 + 1] = v[q][i][1]; tl[kk * 65 + n4 + 2] = v[q][i][2]; tl[kk * 65 + n4 + 3] = v[q][i][3]; } }
        __syncthreads();
#pragma unroll
        for (int q = 0; q < 4; ++q) { const int it = it0 + q * gridDim.x; if (it >= ntiles) break;
            const int ntl = it % nnt, kt = it / nnt, k0 = kt * 64, n0 = ntl * 64; LASP float* tl = tile + q * (64 * 65);
            const int n = tid >> 3, k8 = (tid & 7) * 8; float f[8];
#pragma unroll
            for (int j = 0; j < 8; ++j) f[j] = tl[(k8 + j) * 65 + n];
            *(u32x4*)(dst + pg8::tiled_off((size_t)(n0 + n), k0 + k8, K, true)) = pack8(f); }
        __syncthreads();
    }
}

__device__ __forceinline__ void phase_mod(int wv, const Params& p, LASP unsigned char* lds) {
    const int tid = opaque_tid(wv), lane = tid & 63, wave = wv;
    LASP float* s = (LASP float*)lds;
    LASP float* red = (LASP float*)(lds + 17 * 2048 * 4);
    const float* c = pin(p, I_C); const float* cc = pin(p, I_CCTX);
    for (int i = tid; i < 17 * 2048; i += 512) { const float v = i < 16 * 2048 ? c[i] : cc[i - 16 * 2048]; s[i] = silu_(v); }
    __syncthreads();
    const float* mw = pin(p, I_MODW); const float* mb = pin(p, I_MODB); float* mod = (float*)(p.ws + WS_MOD);
    for (int unit = blockIdx.x; unit < 4 * 192; unit += gridDim.x) {
        const int l = unit / 192, cg = unit % 192, col = cg * 64 + lane;
        for (int i = tid; i < 17 * 64; i += 512) red[i] = 0.f;
        __syncthreads();
        float acc[17];
#pragma unroll
        for (int r = 0; r < 17; ++r) acc[r] = 0.f;
        const float* wp = mw + ((size_t)l * 2048 + wave * 256) * MODW + col;
#pragma unroll 2
        for (int k = 0; k < 256; k += 4) {
            const float w0 = wp[(size_t)(k + 0) * MODW], w1 = wp[(size_t)(k + 1) * MODW], w2 = wp[(size_t)(k + 2) * MODW], w3 = wp[(size_t)(k + 3) * MODW];
#pragma unroll
            for (int r = 0; r < 17; ++r) { const f32x4 sv = *(const LASP f32x4*)(s + r * 2048 + wave * 256 + k); acc[r] += sv[0] * w0 + sv[1] * w1 + sv[2] * w2 + sv[3] * w3; }
        }
        for (int w = 0; w < 8; ++w) {
            if (wave == w) {
#pragma unroll
                for (int r = 0; r < 17; ++r) red[r * 64 + lane] += acc[r];
            }
            __syncthreads();
        }
        for (int i = tid; i < 17 * 64; i += 512) { const int r = i >> 6, cl = i & 63; mod[((size_t)l * 17 + r) * MODW + cg * 64 + cl] = red[i] + mb[(size_t)l * MODW + cg * 64 + cl]; }
        __syncthreads();
    }
}

__device__ __forceinline__ void load_x8(const void* base, bool is_f32, size_t eoff, float (&v)[8]) {
    if (is_f32) { const f32x4 a = *(const f32x4*)((const float*)base + eoff), b = *(const f32x4*)((const float*)base + eoff + 4);
        v[0] = a[0]; v[1] = a[1]; v[2] = a[2]; v[3] = a[3]; v[4] = b[0]; v[5] = b[1]; v[6] = b[2]; v[7] = b[3]; }
    else unpack8(*(const u32x4*)((const bf16*)base + eoff), v);
}
__device__ __forceinline__ void norm_load_pair(const void* xc_src, const void* xl_src, bool src_f32, int row, int lane, float (&va)[4][8], float (&vb)[4][8]) {
    const void* base = row < TC ? xc_src : xl_src; const int rr = row < TC ? row : row - TC;
#pragma unroll
    for (int j = 0; j < 4; ++j) { const int k = j * 512 + lane * 8;
        load_x8(base, src_f32, (size_t)rr * D + k, va[j]); load_x8(base, src_f32, (size_t)(rr + 1) * D + k, vb[j]); }
}
__device__ __forceinline__ void phase_norm(int wv, const void* xc_src, const void* xl_src, bool src_f32, const float* nw, const float* modl, int isc, int ish, bf16* h, int row_lo, const float* pb, bf16* xc_wb, LASP unsigned char* lds) {
    const int tid = opaque_tid(wv), lane = tid & 63;
    LASP float* cs = (LASP float*)lds;
    LASP float* ss = cs + 2048;
    int vp0 = blockIdx.x; asm volatile("" : "+s"(vp0));
#pragma unroll 1
    for (int vp = vp0; vp < 512; vp += gridDim.x) {
        const int part = vp >> 8, vb = vp & 255;
        const int lo = part == 0 ? row_lo : (row_lo > TC ? row_lo : TC), hi = part == 0 ? TC : T;
        if (lo >= hi) continue;
        const int per = (((hi - lo) / 2 + 255) >> 8) * 2;
        int r0 = lo + vb * per; const int r1 = r0 + per < hi ? r0 + per : hi;
        while (r0 < r1) {
            const int mr = r0 < TC ? 16 : (r0 - TC) / SEQ;
            const int seg_end = r0 < TC ? TC : TC + (mr + 1) * SEQ;
            const int re = r1 < seg_end ? r1 : seg_end;
            __syncthreads();
            { const int k = tid * 4; const float* sc = modl + (size_t)mr * MODW + isc * D; const float* sh = modl + (size_t)mr * MODW + ish * D;
              const f32x4 w4 = *(const f32x4*)(nw + k), s4 = *(const f32x4*)(sc + k), h4 = *(const f32x4*)(sh + k); f32x4 c4;
#pragma unroll
              for (int i = 0; i < 4; ++i) c4[i] = w4[i] * (s4[i] + 1.f);
              const int sl = ((((k >> 9) * 2 + ((k >> 2) & 1)) * 64) + ((k >> 3) & 63)) * 4;
              *(LASP f32x4*)(cs + sl) = c4; *(LASP f32x4*)(ss + sl) = h4; }
            __syncthreads();
            float va[4][8], vb[4][8];
            int row = r0 + 2 * wv;
            if (row < re) norm_load_pair(xc_src, xl_src, src_f32, row, lane, va, vb);
            for (; row < re; row += 16) {
                float na[4][8], nb[4][8];
                if (row + 16 < re) norm_load_pair(xc_src, xl_src, src_f32, row + 16, lane, na, nb);
                __builtin_amdgcn_sched_barrier(0);
                const int rowb = row + 1;
                if (pb != nullptr && row < TC) {
#pragma unroll
                    for (int j = 0; j < 4; ++j) { const int k = j * 512 + lane * 8;
                        const f32x4 p0 = *(const f32x4*)(pb + (size_t)row * D + k), p1 = *(const f32x4*)(pb + (size_t)row * D + k + 4), q0 = *(const f32x4*)(pb + (size_t)rowb * D + k), q1 = *(const f32x4*)(pb + (size_t)rowb * D + k + 4);
#pragma unroll
                        for (int i = 0; i < 4; ++i) { va[j][i] += p0[i]; va[j][4 + i] += p1[i]; vb[j][i] += q0[i]; vb[j][4 + i] += q1[i]; }
                        *(u32x4*)(xc_wb + (size_t)row * D + k) = pack8(va[j]); *(u32x4*)(xc_wb + (size_t)rowb * D + k) = pack8(vb[j]); }
                }
                float sa = 0.f, sb = 0.f;
#pragma unroll
                for (int j = 0; j < 4; ++j)
#pragma unroll
                    for (int i = 0; i < 8; ++i) { sa += va[j][i] * va[j][i]; sb += vb[j][i] * vb[j][i]; }
#pragma unroll
                for (int o = 32; o > 0; o >>= 1) { sa += shx(sa, o, lane); sb += shx(sb, o, lane); }
                const float ra = rsqrtf(sa * (1.f / D) + EPS), rbs = rsqrtf(sb * (1.f / D) + EPS);
#pragma unroll
                for (int j = 0; j < 4; ++j) { const int k = j * 512 + lane * 8; float oa[8], ob[8];
                    const f32x4 c0 = *(const LASP f32x4*)(cs + ((j * 2 + 0) * 64 + lane) * 4), c1 = *(const LASP f32x4*)(cs + ((j * 2 + 1) * 64 + lane) * 4);
                    const f32x4 h0 = *(const LASP f32x4*)(ss + ((j * 2 + 0) * 64 + lane) * 4), h1 = *(const LASP f32x4*)(ss + ((j * 2 + 1) * 64 + lane) * 4);
#pragma unroll
                    for (int i = 0; i < 4; ++i) {
                        oa[i] = va[j][i] * ra * c0[i] + h0[i]; oa[4 + i] = va[j][4 + i] * ra * c1[i] + h1[i];
                        ob[i] = vb[j][i] * rbs * c0[i] + h0[i]; ob[4 + i] = vb[j][4 + i] * rbs * c1[i] + h1[i]; }
                    *(u32x4*)(h + pg8::tiled_off((size_t)row, k, D)) = pack8(oa); *(u32x4*)(h + pg8::tiled_off((size_t)rowb, k, D)) = pack8(ob); }
                __builtin_amdgcn_sched_barrier(0);
#pragma unroll
                for (int j = 0; j < 4; ++j)
#pragma unroll
                    for (int i = 0; i < 8; ++i) { va[j][i] = na[j][i]; vb[j][i] = nb[j][i]; }
            }
            r0 = re;
        }
    }
    __syncthreads();
}
__device__ __forceinline__ void phase_final_norm(int wv, const bf16* x, float* out, const float* nw) {
    const int tid = opaque_tid(wv), lane = tid & 63, wave = wv;
    const int gw = blockIdx.x * 8 + wave, nwv = gridDim.x * 8;
    for (int row = gw; row < TL; row += nwv) {
        float v[4][8]; float ss = 0.f;
#pragma unroll
        for (int j = 0; j < 4; ++j) unpack8(*(const u32x4*)(x + (size_t)row * D + j * 512 + lane * 8), v[j]);
#pragma unroll
        for (int j = 0; j < 4; ++j)
#pragma unroll
            for (int i = 0; i < 8; ++i) ss += v[j][i] * v[j][i];
        ss = wave_sum(ss, lane);
        const float rs = rsqrtf(ss * (1.f / D) + EPS);
#pragma unroll
        for (int j = 0; j < 4; ++j) { const int k = j * 512 + lane * 8; const f32x4 w0 = *(const f32x4*)(nw + k), w1 = *(const f32x4*)(nw + k + 4); f32x4 o0, o1;
#pragma unroll
            for (int i = 0; i < 4; ++i) { o0[i] = v[j][i] * rs * w0[i]; o1[i] = v[j][4 + i] * rs * w1[i]; }
            *(f32x4*)(out + (size_t)row * D + k) = o0; *(f32x4*)(out + (size_t)row * D + k + 4) = o1; }
    }
}

typedef short s16x4 __attribute__((ext_vector_type(4)));
typedef short s16x8 __attribute__((ext_vector_type(8)));
__device__ __forceinline__ s16x4 tr_read4(LASP const unsigned char* p) { return __builtin_amdgcn_ds_read_tr16_b64_v4i16((LASP s16x4*)p); }
__device__ __forceinline__ s16x4 cvt4(const f32x4 v) { u32x2 r; r.x = pg8::cvt_pk_bf16(v[0], v[1]); r.y = pg8::cvt_pk_bf16(v[2], v[3]); return __builtin_bit_cast(s16x4, r); }
__device__ __forceinline__ float logsigmoid_(float x) { return fminf(x, 0.f) - log1p_pos(__expf(-fabsf(x))); }
#define MFMA16(a, b, c) __builtin_amdgcn_mfma_f32_16x16x16bf16_1k((a), (b), (c), 0, 0, 0)
#define MFMA32(a, b, c) __builtin_amdgcn_mfma_f32_16x16x32_bf16((a), (b), (c), 0, 0, 0)

__device__ __forceinline__ void phase_mlstm_chunk(int wv, const bf16* u, const float* gates, const float* gate_b, bf16* so, LASP unsigned char* lds) {
    constexpr int L = 64, NC = (CTX + SEQ) / L, RSQ = 528, RSK = 544, RSV = 288, RSP = 144;
    constexpr int OFF_Q = 0, OFF_K = OFF_Q + L * RSQ, OFF_V = OFF_K + L * RSK, OFF_V2 = OFF_V + L * RSV, OFF_P = OFF_V2 + L * RSV, OFF_F = OFF_P + L * RSP;
    const int tid = opaque_tid(wv), lane = tid & 63, wave = wv, g = lane >> 4, l15 = lane & 15;
    LASP float* fb = (LASP float*)(lds + OFF_F);
    LASP float* s_gv = fb;
    LASP float* s_misc = fb + 512;
    LASP float* s_denp = fb + 520; LASP float* s_qn = fb + 776; LASP float* s_n = fb + 840;
    LASP bf16* s_wb = (LASP bf16*)(fb + 1864);
    for (int item = blockIdx.x; item < BATCH * 4 * 2 * 4; item += gridDim.x) {
        const int b = item >> 5, h = (item >> 3) & 3, dir = (item >> 2) & 1, vq = item & 3;
        const float bi = gate_b[dir * 4 + h], bfg = gate_b[(2 + dir) * 4 + h];
        f32x4 S[16];
#pragma unroll
        for (int j = 0; j < 16; ++j) S[j] = (f32x4){0.f, 0.f, 0.f, 0.f};
        s_n[opaque_tid(wv)] = 0.f;
        f32x4 Nn[2] = {(f32x4){0.f, 0.f, 0.f, 0.f}, (f32x4){0.f, 0.f, 0.f, 0.f}};
        u32x4 pq[4], pk[4], pv[2]; float gi = 0.f, gf = 0.f;
        const int dsq = (dir ? -16 : 16) * OD_MAIN * 2, dsv = (dir ? -32 : 32) * OD_MAIN * 2;
#define MLSTM_LOAD(c) do { const char* ub_ = (const char*)u + (size_t)chunk_row0(b, dir, (c)) * (OD_MAIN * 2); const int t_ = opaque_tid(wv);     \
            const unsigned voq = (unsigned)((rix(dir, t_ >> 5) * OD_MAIN + OU_QK + h * 256 + (t_ & 31) * 8) * 2), vov = (unsigned)((rix(dir, t_ >> 4) * OD_MAIN + OU_V + h * 512 + vq * 128 + (t_ & 15) * 8) * 2); \
            _Pragma("unroll") for (int i = 0; i < 4; ++i) { const char* uq_ = ub_ + (size_t)(unsigned)(voq + i * dsq); pq[i] = *(const u32x4*)uq_; pk[i] = *(const u32x4*)(uq_ + 2048); } \
            _Pragma("unroll") for (int i = 0; i < 2; ++i) pv[i] = *(const u32x4*)(ub_ + (size_t)(unsigned)(vov + i * dsv)); } while (0)
#define MLSTM_GLOAD(c) do { const float* gb_ = gates + (size_t)chunk_row0(b, dir, (c)) * 32 + dir * 4 + h; gi = gb_[rix(dir, lane) * 32]; gf = gb_[rix(dir, lane) * 32 + 8]; } while (0)
#define MLSTM_GPREP(par) do { const float li_ = gi + bi; float x_ = logsigmoid_(gf + bfg); \
            _Pragma("unroll") for (int o = 1; o < 64; o <<= 1) { const float y_ = shup(x_, o, lane); if (lane >= o) x_ += y_; } \
            const float btot_ = rdlane(x_, 63); LASP float* gp_ = s_gv + (par) * 256; \
            const float w_ = __expf(btot_ - x_ + li_); gp_[lane] = x_; gp_[64 + lane] = li_; gp_[128 + lane] = w_; gp_[192 + lane] = __expf(x_); \
            s_wb[(par) * 64 + lane] = (bf16)(pg8::cvt_pk_bf16(w_, 0.f) & 0xffffu); \
            if (lane == 0) s_misc[par] = __expf(btot_); } while (0)
        MLSTM_LOAD(0);
        if (wave == 0) { MLSTM_GLOAD(0); MLSTM_GPREP(0); MLSTM_GLOAD(1); }
        for (int c = 0; c < NC; ++c) {
            const int par = c & 1;
            LASP float* s_b = s_gv + par * 256; LASP float* s_li = s_b + 64; LASP float* s_w = s_b + 128; LASP float* s_eb = s_b + 192;
            LASP float* n_cur = s_n + par * 256; LASP float* n_nxt = s_n + (par ^ 1) * 256;
#pragma unroll
            for (int i = 0; i < 4; ++i) { const int idx = tid + i * 512, r = idx >> 5, pc = idx & 31; *(LASP u32x4*)(lds + OFF_Q + r * RSQ + pc * 16) = pq[i]; *(LASP u32x4*)(lds + OFF_K + r * RSK + pc * 16) = pk[i]; }
#pragma unroll
            for (int i = 0; i < 2; ++i) { const int idx = tid + i * 512, r = idx >> 4, pc = idx & 15; *(LASP u32x4*)(lds + OFF_V + r * RSV + pc * 16) = pv[i]; }
            __syncthreads();
#pragma unroll
            for (int i = 0; i < 2; ++i) { const int idx = tid + i * 512, r = idx >> 4, pc = idx & 15; float v8[8]; unpack8(pv[i], v8); const float w = s_w[r];
#pragma unroll
                for (int j = 0; j < 8; ++j) v8[j] *= w;
                *(LASP u32x4*)(lds + OFF_V2 + r * RSV + pc * 16) = pack8(v8); }
            if (c + 1 < NC) MLSTM_LOAD(c + 1);
            if (wave < 6) {
                const int tb = wave == 0 ? 0 : wave == 1 ? 1 : wave < 4 ? 2 : 3, sb0 = (wave == 3 || wave == 5) ? 2 : 0, ntl = (wave == 0 || wave == 3) ? 1 : 2;
                f32x4 ag0 = (f32x4){0.f, 0.f, 0.f, 0.f}, ag1 = (f32x4){0.f, 0.f, 0.f, 0.f};
#pragma unroll
                for (int kh = 0; kh < 2; ++kh) { s16x8 Gb[4], Ga0[4], Ga1[4];
#pragma unroll
                  for (int ks = 0; ks < 4; ++ks) { Gb[ks] = *(const LASP s16x8*)(lds + OFF_Q + (16 * tb + l15) * RSQ + (kh * 4 + ks) * 64 + g * 16);
                      Ga0[ks] = *(const LASP s16x8*)(lds + OFF_K + (16 * sb0 + l15) * RSK + (kh * 4 + ks) * 64 + g * 16);
                      Ga1[ks] = *(const LASP s16x8*)(lds + OFF_K + (16 * (sb0 + ntl - 1) + l15) * RSK + (kh * 4 + ks) * 64 + g * 16); }
                  __builtin_amdgcn_sched_barrier(0);
#pragma unroll
                  for (int ks = 0; ks < 4; ++ks) { ag0 = MFMA32(Ga0[ks], Gb[ks], ag0); ag1 = MFMA32(Ga1[ks], Gb[ks], ag1); } }
                const int t = 16 * tb + l15; const float bt = s_b[t];
#pragma unroll
                for (int q = 0; q < 2; ++q) { if (q >= ntl) break; const int sb = sb0 + q; const f32x4 ag = q == 0 ? ag0 : ag1; float pvv[4], rs = 0.f;
#pragma unroll
                    for (int i = 0; i < 4; ++i) { const int sidx = 16 * sb + 4 * g + i; pvv[i] = sidx <= t ? ag[i] * __expf(bt - s_b[sidx] + s_li[sidx]) : 0.f; rs += pvv[i]; }
                    u32x2 pk2; pk2.x = pg8::cvt_pk_bf16(pvv[0], pvv[1]); pk2.y = pg8::cvt_pk_bf16(pvv[2], pvv[3]);
                    *(LASP u32x2*)(lds + OFF_P + t * RSP + (16 * sb + 4 * g) * 2) = pk2;
                    rs += shx(rs, 16, lane); rs += shx(rs, 32, lane);
                    if (g == 0) s_denp[sb * 64 + t] = rs; }
                if (wave == 0 && c + 1 < NC) MLSTM_GPREP(par ^ 1);
            } else {
                LASP const float* nsum = n_cur;
                const int t = (wave - 6) * 32 + (lane >> 1), kh = lane & 1; float acc = 0.f;
#pragma unroll
                for (int i = 0; i < 16; ++i) { float q8[8]; unpack8(*(const LASP u32x4*)(lds + OFF_Q + t * RSQ + (kh * 128 + i * 8) * 2), q8);
                    const f32x4 n0 = *(const LASP f32x4*)(nsum + kh * 128 + i * 8), n1 = *(const LASP f32x4*)(nsum + kh * 128 + i * 8 + 4);
                    acc += (q8[0] * n0[0] + q8[1] * n0[1]) + (q8[2] * n0[2] + q8[3] * n0[3]) + (q8[4] * n1[0] + q8[5] * n1[1]) + (q8[6] * n1[2] + q8[7] * n1[3]); }
                acc += shx(acc, 1, lane);
                if (kh == 0) s_qn[t] = acc;
            }
            __syncthreads();
            f32x4 acc[4];
#pragma unroll
            for (int tb = 0; tb < 4; ++tb) acc[tb] = (f32x4){0.f, 0.f, 0.f, 0.f};
            const float gam = s_misc[par];
            {   s16x4 Bc[4], Bn[4], Ac[4], An[4], V2t[4];
#pragma unroll
                for (int sb = 0; sb < 4; ++sb) V2t[sb] = tr_read4(lds + OFF_V2 + (16 * sb + 4 * g + (l15 >> 2)) * RSV + (16 * wave + 4 * (l15 & 3)) * 2);
#define MLSTM_LDB(dst, j) do { _Pragma("unroll") for (int tb = 0; tb < 4; ++tb) \
                    dst[tb] = *(const LASP s16x4*)(lds + OFF_Q + (16 * tb + l15) * RSQ + (16 * (j) + 4 * g) * 2); } while (0)
#define MLSTM_LDA(dst, j) do { _Pragma("unroll") for (int sb = 0; sb < 4; ++sb) \
                    dst[sb] = tr_read4(lds + OFF_K + (16 * sb + 4 * g + (l15 >> 2)) * RSK + (16 * (j) + 4 * (l15 & 3)) * 2); } while (0)
                MLSTM_LDB(Bc, 0); MLSTM_LDA(Ac, 0);
#pragma unroll
                for (int j = 0; j < 16; ++j) {
                    if (j < 15) { MLSTM_LDB(Bn, j + 1); MLSTM_LDA(An, j + 1); }
                    __builtin_amdgcn_sched_barrier(0);
                    { const s16x4 A = cvt4(S[j]);
#pragma unroll
                      for (int tb = 0; tb < 4; ++tb) acc[tb] = MFMA16(A, Bc[tb], acc[tb]);
                      S[j] = S[j] * gam;
#pragma unroll
                      for (int sb = 0; sb < 4; ++sb) S[j] = MFMA16(Ac[sb], V2t[sb], S[j]);
                      if ((j >> 1) == wave) {
                          f32x4 nn = Nn[j & 1] * gam;
#pragma unroll
                          for (int sb = 0; sb < 4; ++sb) nn = MFMA16(Ac[sb], *(const LASP s16x4*)(s_wb + par * 64 + 16 * sb + 4 * g), nn);
                          Nn[j & 1] = nn;
                          if (l15 == 0) *(LASP f32x4*)(n_nxt + 16 * j + 4 * g) = nn; } }
                    __builtin_amdgcn_sched_barrier(0);
#pragma unroll
                    for (int i = 0; i < 4; ++i) { Bc[i] = Bn[i]; Ac[i] = An[i]; }
                }
#undef MLSTM_LDB
#undef MLSTM_LDA
            }
            {   s16x4 Vt[4], Pb[10]; float ebv[4];
#pragma unroll
                for (int sb = 0; sb < 4; ++sb) Vt[sb] = tr_read4(lds + OFF_V + (16 * sb + 4 * g + (l15 >> 2)) * RSV + (16 * wave + 4 * (l15 & 3)) * 2);
#pragma unroll
                for (int tb = 0; tb < 4; ++tb) { ebv[tb] = s_eb[16 * tb + l15];
#pragma unroll
                    for (int sb = 0; sb <= tb; ++sb) Pb[(tb * (tb + 1)) / 2 + sb] = *(const LASP s16x4*)(lds + OFF_P + (16 * tb + l15) * RSP + (16 * sb + 4 * g) * 2); }
                __builtin_amdgcn_sched_barrier(0);
#pragma unroll
                for (int tb = 0; tb < 4; ++tb) { acc[tb] = acc[tb] * ebv[tb];
#pragma unroll
                    for (int sb = 0; sb <= tb; ++sb) acc[tb] = MFMA16(Vt[sb], Pb[(tb * (tb + 1)) / 2 + sb], acc[tb]); }
            }
#pragma unroll
            for (int tb = 0; tb < 4; ++tb) { const int t = 16 * tb + l15; float den = s_eb[t] * s_qn[t];
#pragma unroll
                for (int sb = 0; sb <= tb; ++sb) den += s_denp[sb * 64 + t];
                const float sc = 1.f / fmaxf(fabsf(den), 1.f); const f32x4 o = acc[tb] * sc;
                u32x2 pk2; pk2.x = pg8::cvt_pk_bf16(o[0], o[1]); pk2.y = pg8::cvt_pk_bf16(o[2], o[3]);
                *(u32x2*)((char*)(so + ((size_t)dir * T + chunk_row0(b, dir, c)) * D + h * 512 + vq * 128 + 16 * wave) + (size_t)(unsigned)((rix(dir, t) * D + 4 * g) * 2)) = pk2; }
            if (wave == 0 && c + 2 < NC) MLSTM_GLOAD(c + 2);
            __syncthreads();
        }
#undef MLSTM_LOAD
#undef MLSTM_GLOAD
#undef MLSTM_GPREP
    }
}

__device__ __forceinline__ void phase_ssd_chunk(int wv, const bf16* u, const float* gates, const float* a_log, const float* dt_bias, bf16* so, LASP unsigned char* lds) {
    constexpr int L = 64, RS = 272, RSK = 288, RSP = 144;
    constexpr int OFF_Q = 0, OFF_K = L * RS, OFF_V1 = OFF_K + L * RSK, OFF_V2 = OFF_V1 + L * RSK, OFF_P = OFF_V2 + L * RSK, OFF_F = OFF_P + 2 * L * RSP;
    const int tid = opaque_tid(wv), lane = tid & 63, wave = wv, g = lane >> 4, l15 = lane & 15, hh = wave >> 2;
    LASP float* fb = (LASP float*)(lds + OFF_F);
    LASP float* s_gvv = fb;
    LASP float* s_gm = fb + 1024;
    for (int item = blockIdx.x; item < BATCH * 8 * 2; item += gridDim.x) {
        const int b = item >> 4, hp = (item >> 1) & 7, dir = item & 1, grp = hp >> 2, hA = 2 * hp;
        const float Aneg = -__expf(a_log[dir * 16 + hA + (wave & 1)]), dtb = dt_bias[dir * 16 + hA + (wave & 1)];
        f32x4 S[8];
#pragma unroll
        for (int j = 0; j < 8; ++j) S[j] = (f32x4){0.f, 0.f, 0.f, 0.f};
        u32x4 pq[2], pk[2], pv[2]; float gd = 0.f;
        const int dso = (dir ? -32 : 32) * EV_MAIN * 2;
#define SSD_LOAD(c) do { const char* ub_ = (const char*)u + (size_t)chunk_row0(b, dir, (c)) * (EV_MAIN * 2); const int t_ = opaque_tid(wv); \
            const unsigned vo = (unsigned)((rix(dir, t_ >> 4) * EV_MAIN + EU_XBC + (t_ & 15) * 8) * 2); \
            _Pragma("unroll") for (int i = 0; i < 2; ++i) { const char* ur_ = ub_ + (size_t)(unsigned)(vo + i * dso); \
                pq[i] = *(const u32x4*)(ur_ + (1280 + grp * 128) * 2); pk[i] = *(const u32x4*)(ur_ + (1024 + grp * 128) * 2); pv[i] = *(const u32x4*)(ur_ + hA * 64 * 2); } \
            } while (0)
#define SSD_GLOAD(c) do { gd = gates[((size_t)chunk_row0(b, dir, (c)) + rix(dir, lane)) * 32 + dir * 16 + hA + (wave & 1)]; } while (0)
#define SSD_GPREP(par) do { const float dtv_ = softplus_(gd + dtb); float x_ = Aneg * dtv_; \
            _Pragma("unroll") for (int o = 1; o < 64; o <<= 1) { const float y_ = shup(x_, o, lane); if (lane >= o) x_ += y_; } \
            const float btot_ = rdlane(x_, 63); LASP float* gp_ = s_gvv + (par) * 512 + (wave & 1) * 64; \
            gp_[lane] = dtv_; gp_[128 + lane] = x_; gp_[256 + lane] = __expf(x_); gp_[384 + lane] = __expf(btot_ - x_); \
            if (lane == 0) s_gm[(par) * 2 + (wave & 1)] = __expf(btot_); } while (0)
        SSD_LOAD(0);
        if (wave >= 6) { SSD_GLOAD(0); SSD_GPREP(0); SSD_GLOAD(1); }
        for (int c = 0; c < (CTX + SEQ) / L; ++c) {
            const int par = c & 1;
            LASP float* s_dt = s_gvv + par * 512; LASP float* s_b = s_dt + 128; LASP float* s_eb = s_dt + 256; LASP float* s_w = s_dt + 384; LASP float* s_gam = s_gm + par * 2;
#pragma unroll
            for (int i = 0; i < 2; ++i) { const int idx = tid + i * 512, r = idx >> 4, pc = idx & 15; *(LASP u32x4*)(lds + OFF_Q + r * RS + pc * 16) = pq[i]; *(LASP u32x4*)(lds + OFF_K + r * RSK + pc * 16) = pk[i]; }
            __syncthreads();
#pragma unroll
            for (int i = 0; i < 2; ++i) { const int idx = tid + i * 512, r = idx >> 4, pc = idx & 15, hc = pc >> 3; const float dtv = s_dt[hc * 64 + r], w = s_w[hc * 64 + r];
                float x8[8]; unpack8(pv[i], x8);
#pragma unroll
                for (int j = 0; j < 8; ++j) x8[j] *= dtv;
                *(LASP u32x4*)(lds + OFF_V1 + r * RSK + pc * 16) = pack8(x8);
#pragma unroll
                for (int j = 0; j < 8; ++j) x8[j] *= w;
                *(LASP u32x4*)(lds + OFF_V2 + r * RSK + pc * 16) = pack8(x8); }
            if (c + 1 < (CTX + SEQ) / L) SSD_LOAD(c + 1);
            if (wave < 6) {
                const int tb = wave == 0 ? 0 : wave == 1 ? 1 : wave < 4 ? 2 : 3, sb0 = (wave == 3 || wave == 5) ? 2 : 0, ntl = (wave == 0 || wave == 3) ? 1 : 2;
                f32x4 ag0 = (f32x4){0.f, 0.f, 0.f, 0.f}, ag1 = (f32x4){0.f, 0.f, 0.f, 0.f};
                { s16x8 Gb[4], Ga0[4], Ga1[4];
#pragma unroll
                  for (int ks = 0; ks < 4; ++ks) { Gb[ks] = *(const LASP s16x8*)(lds + OFF_Q + (16 * tb + l15) * RS + ks * 64 + g * 16);
                      Ga0[ks] = *(const LASP s16x8*)(lds + OFF_K + (16 * sb0 + l15) * RSK + ks * 64 + g * 16);
                      Ga1[ks] = *(const LASP s16x8*)(lds + OFF_K + (16 * (sb0 + ntl - 1) + l15) * RSK + ks * 64 + g * 16); }
                  __builtin_amdgcn_sched_barrier(0);
#pragma unroll
                  for (int ks = 0; ks < 4; ++ks) { ag0 = MFMA32(Ga0[ks], Gb[ks], ag0); ag1 = MFMA32(Ga1[ks], Gb[ks], ag1); } }
                const int t = 16 * tb + l15;
#pragma unroll
                for (int q = 0; q < 2; ++q) { if (q >= ntl) break; const int sb = sb0 + q; const f32x4 ag = q == 0 ? ag0 : ag1;
#pragma unroll
                    for (int hd = 0; hd < 2; ++hd) { const float bt = s_b[hd * 64 + t]; float pvv[4];
#pragma unroll
                        for (int i = 0; i < 4; ++i) { const int sidx = 16 * sb + 4 * g + i; pvv[i] = sidx <= t ? ag[i] * __expf(bt - s_b[hd * 64 + sidx]) : 0.f; }
                        u32x2 pk2; pk2.x = pg8::cvt_pk_bf16(pvv[0], pvv[1]); pk2.y = pg8::cvt_pk_bf16(pvv[2], pvv[3]);
                        *(LASP u32x2*)(lds + OFF_P + hd * L * RSP + t * RSP + (16 * sb + 4 * g) * 2) = pk2; } }
            } else if (c + 1 < (CTX + SEQ) / L) SSD_GPREP(par ^ 1);
            __syncthreads();
            f32x4 acc[4];
#pragma unroll
            for (int tb = 0; tb < 4; ++tb) acc[tb] = (f32x4){0.f, 0.f, 0.f, 0.f};
            {   s16x4 Bc[16], Bn[16];
#define SSD_LDB(dst, jb) do { _Pragma("unroll") for (int jj = 0; jj < 4; ++jj) _Pragma("unroll") for (int tb = 0; tb < 4; ++tb) \
                    dst[jj * 4 + tb] = *(const LASP s16x4*)(lds + OFF_Q + (16 * tb + l15) * RS + (16 * ((jb) * 4 + jj) + 4 * g) * 2); } while (0)
                SSD_LDB(Bc, 0);
#pragma unroll
                for (int jb = 0; jb < 2; ++jb) {
                    if (jb < 1) SSD_LDB(Bn, jb + 1);
                    __builtin_amdgcn_sched_barrier(0);
#pragma unroll
                    for (int jj = 0; jj < 4; ++jj) { const s16x4 A = cvt4(S[jb * 4 + jj]);
#pragma unroll
                        for (int tb = 0; tb < 4; ++tb) acc[tb] = MFMA16(A, Bc[jj * 4 + tb], acc[tb]); }
                    __builtin_amdgcn_sched_barrier(0);
#pragma unroll
                    for (int i = 0; i < 16; ++i) Bc[i] = Bn[i];
                }
#undef SSD_LDB
            }
            s16x4 Vt[4];
            {   s16x4 Pb[10]; float ebv[4];
#pragma unroll
                for (int sb = 0; sb < 4; ++sb) Vt[sb] = tr_read4(lds + OFF_V1 + (16 * sb + 4 * g + (l15 >> 2)) * RSK + (16 * wave + 4 * (l15 & 3)) * 2);
#pragma unroll
                for (int tb = 0; tb < 4; ++tb) { ebv[tb] = s_eb[hh * 64 + 16 * tb + l15];
#pragma unroll
                    for (int sb = 0; sb <= tb; ++sb) Pb[(tb * (tb + 1)) / 2 + sb] = *(const LASP s16x4*)(lds + OFF_P + hh * L * RSP + (16 * tb + l15) * RSP + (16 * sb + 4 * g) * 2); }
                __builtin_amdgcn_sched_barrier(0);
#pragma unroll
                for (int tb = 0; tb < 4; ++tb) { acc[tb] = acc[tb] * ebv[tb];
#pragma unroll
                    for (int sb = 0; sb <= tb; ++sb) acc[tb] = MFMA16(Vt[sb], Pb[(tb * (tb + 1)) / 2 + sb], acc[tb]); }
            }
#pragma unroll
            for (int tb = 0; tb < 4; ++tb) { const int t = 16 * tb + l15; const f32x4 o = acc[tb];
                u32x2 pk2; pk2.x = pg8::cvt_pk_bf16(o[0], o[1]); pk2.y = pg8::cvt_pk_bf16(o[2], o[3]);
                *(u32x2*)((char*)(so + ((size_t)dir * T + chunk_row0(b, dir, c)) * D + hA * 64 + 16 * wave) + (size_t)(unsigned)((rix(dir, t) * D + 4 * g) * 2)) = pk2; }
#pragma unroll
            for (int sb = 0; sb < 4; ++sb) Vt[sb] = tr_read4(lds + OFF_V2 + (16 * sb + 4 * g + (l15 >> 2)) * RSK + (16 * wave + 4 * (l15 & 3)) * 2);
            if (wave >= 6 && c + 2 < (CTX + SEQ) / L) SSD_GLOAD(c + 2);
            const float gam = s_gam[hh];
            {   s16x4 Ac[16], An[16];
#define SSD_LDA(dst, jb) do { _Pragma("unroll") for (int jj = 0; jj < 4; ++jj) _Pragma("unroll") for (int sb = 0; sb < 4; ++sb) \
                    dst[jj * 4 + sb] = tr_read4(lds + OFF_K + (16 * sb + 4 * g + (l15 >> 2)) * RSK + (16 * ((jb) * 4 + jj) + 4 * (l15 & 3)) * 2); } while (0)
                SSD_LDA(Ac, 0);
#pragma unroll
                for (int jb = 0; jb < 2; ++jb) {
                    if (jb < 1) SSD_LDA(An, jb + 1);
                    __builtin_amdgcn_sched_barrier(0);
#pragma unroll
                    for (int jj = 0; jj < 4; ++jj) { S[jb * 4 + jj] = S[jb * 4 + jj] * gam;
#pragma unroll
                        for (int sb = 0; sb < 4; ++sb) S[jb * 4 + jj] = MFMA16(Ac[jj * 4 + sb], Vt[sb], S[jb * 4 + jj]); }
                    __builtin_amdgcn_sched_barrier(0);
#pragma unroll
                    for (int i = 0; i < 16; ++i) Ac[i] = An[i];
                }
#undef SSD_LDA
            }
            __syncthreads();
        }
#undef SSD_LOAD
#undef SSD_GLOAD
#undef SSD_GPREP
    }
}

__device__ __forceinline__ void phase_hgrn_chunk(int wv, const bf16* u, const float* hlb, int e, bf16* so, LASP unsigned char* lds) {
    constexpr int L = 64, RS = 272, RSK = 288, RSP = 40;
    constexpr int OFF_Z = 0  , OFF_Q = L * RS  , OFF_KP = 2 * L * RS, OFF_V = OFF_KP + L * RSK, OFF_P = OFF_V + L * RSK, OFF_G = OFF_P + 4 * 16 * RSP;
    const int tid = opaque_tid(wv), lane = tid & 63, wave = wv, g = lane >> 4, l15 = lane & 15;
    LASP float* s_g = (LASP float*)(lds + OFF_G);
    for (int item = blockIdx.x; item < BATCH * 8 * 2; item += gridDim.x) {
        const int b = item >> 4, h = (item >> 1) & 7, dir = item & 1;
        const int ep = tid & 63, esub = (tid >> 6) & 3;
        f32x2 lb2 = (f32x2){0.f, 0.f};
        if (e != 0) { lb2.x = sigmoid_(hlb[1024 + h * 128 + 2 * ep] - hlb[h * 128 + 2 * ep]); lb2.y = sigmoid_(hlb[1024 + h * 128 + 2 * ep + 1] - hlb[h * 128 + 2 * ep + 1]); }
        const f32x2 oml2 = (f32x2){1.f, 1.f} - lb2;
        f32x4 S[8];
#pragma unroll
        for (int j = 0; j < 8; ++j) S[j] = (f32x4){0.f, 0.f, 0.f, 0.f};
        u32x4 pz[2], pq[2], pv[2];
        const int dso = (dir ? -32 : 32) * EV_MAIN * 2;
#define HGRN_LOAD(c) do { const char* ub_ = (const char*)u + (size_t)chunk_row0(b, dir, (c)) * (EV_MAIN * 2); const int t_ = opaque_tid(wv); \
            const unsigned vo = (unsigned)((rix(dir, t_ >> 4) * EV_MAIN + h * 128 + (t_ & 15) * 8) * 2); \
            _Pragma("unroll") for (int i = 0; i < 2; ++i) { const char* ur_ = ub_ + (size_t)(unsigned)(vo + i * dso); \
                pz[i] = *(const u32x4*)(ur_ + (EU_F + dir * 1024) * 2); pq[i] = *(const u32x4*)(ur_ + EU_Q * 2); pv[i] = *(const u32x4*)(ur_ + EU_I * 2); } } while (0)
        HGRN_LOAD(0);
        for (int c = 0; c < (CTX + SEQ) / L; ++c) {
#pragma unroll
            for (int i = 0; i < 2; ++i) { const int idx = tid + i * 512, r = idx >> 4, pc = idx & 15;
                *(LASP u32x4*)(lds + OFF_Z + r * RS + pc * 16) = pz[i]; *(LASP u32x4*)(lds + OFF_Q + r * RS + pc * 16) = pq[i]; *(LASP u32x4*)(lds + OFF_V + r * RSK + pc * 16) = pv[i]; }
            __syncthreads();
            if (c + 1 < (CTX + SEQ) / L) HGRN_LOAD(c + 1);
            if (wave < 4) { f32x2 pf[16], kin[16]; f32x2 run = (f32x2){1.f, 1.f};
#pragma unroll
              for (int t = 0; t < 16; ++t) { const unsigned zw = *(const LASP unsigned*)(lds + OFF_Z + (esub * 16 + t) * RS + ep * 4);
                  const f32x2 zf = (f32x2){fminf(bf_lo(zw), 30.f), fminf(bf_hi(zw), 30.f)};
                  const f32x2 ez = (f32x2){__expf(zf.x), __expf(zf.y)}, sneg = (f32x2){__builtin_amdgcn_rcpf(1.f + ez.x), __builtin_amdgcn_rcpf(1.f + ez.y)}, spos = ez * sneg;
                  const f32x2 f = lb2 + oml2 * spos; kin[t] = oml2 * sneg; run = run * f; run.x = fmaxf(run.x, 1e-30f); run.y = fmaxf(run.y, 1e-30f); pf[t] = run; }
#pragma unroll
              for (int t = 0; t < 16; ++t) { LASP unsigned* zp = (LASP unsigned*)(lds + OFF_Z + (esub * 16 + t) * RS + ep * 4); LASP unsigned* qp = (LASP unsigned*)(lds + OFF_Q + (esub * 16 + t) * RS + ep * 4);
                  LASP unsigned* kp = (LASP unsigned*)(lds + OFF_KP + (esub * 16 + t) * RSK + ep * 4);
                  const unsigned qw = *qp; const f32x2 qr = (f32x2){bf_lo(qw), bf_hi(qw)};
                  const f32x2 sg = (f32x2){__builtin_amdgcn_rcpf(1.f + __expf(-qr.x)), __builtin_amdgcn_rcpf(1.f + __expf(-qr.y))}, q = qr * sg * pf[t];
                  const f32x2 ipf = (f32x2){__builtin_amdgcn_rcpf(pf[t].x), __builtin_amdgcn_rcpf(pf[t].y)}, ks = kin[t] * ipf, kpv = ks * run;
                  *qp = pg8::cvt_pk_bf16(q.x, q.y); *zp = pg8::cvt_pk_bf16(ks.x, ks.y); *kp = pg8::cvt_pk_bf16(kpv.x, kpv.y); }
              *(LASP f32x2*)(s_g + esub * 128 + 2 * ep) = run; }
            __syncthreads();
            if (wave < 4) {
                f32x4 ag = (f32x4){0.f, 0.f, 0.f, 0.f};
#pragma unroll
                for (int ks = 0; ks < 4; ++ks) {
                    const s16x8 A = *(const LASP s16x8*)(lds + OFF_Z + (16 * wave + l15) * RS + ks * 64 + g * 16);
                    const s16x8 B = *(const LASP s16x8*)(lds + OFF_Q + (16 * wave + l15) * RS + ks * 64 + g * 16);
                    ag = MFMA32(A, B, ag);
                }
                float pvv[4];
#pragma unroll
                for (int i = 0; i < 4; ++i) pvv[i] = (4 * g + i) <= l15 ? ag[i] : 0.f;
                u32x2 pk2; pk2.x = pg8::cvt_pk_bf16(pvv[0], pvv[1]); pk2.y = pg8::cvt_pk_bf16(pvv[2], pvv[3]);
                *(LASP u32x2*)(lds + OFF_P + wave * 16 * RSP + l15 * RSP + 8 * g) = pk2;
            }
            __syncthreads();
#pragma unroll
            for (int sub = 0; sub < 4; ++sub) {
                f32x4 acc = (f32x4){0.f, 0.f, 0.f, 0.f};
                s16x4 Bq[8], Ak[8]; f32x4 gsv[8];
#pragma unroll
                for (int j = 0; j < 8; ++j) Bq[j] = *(const LASP s16x4*)(lds + OFF_Q + (16 * sub + l15) * RS + (16 * j + 4 * g) * 2);
                const s16x4 Vt = tr_read4(lds + OFF_V + (16 * sub + 4 * g + (l15 >> 2)) * RSK + (16 * wave + 4 * (l15 & 3)) * 2);
                const s16x4 Pt = *(const LASP s16x4*)(lds + OFF_P + sub * 16 * RSP + l15 * RSP + 8 * g);
#pragma unroll
                for (int j = 0; j < 8; ++j) { Ak[j] = tr_read4(lds + OFF_KP + (16 * sub + 4 * g + (l15 >> 2)) * RSK + (16 * j + 4 * (l15 & 3)) * 2); gsv[j] = *(const LASP f32x4*)(s_g + sub * 128 + 16 * j + 4 * g); }
                __builtin_amdgcn_sched_barrier(0);
                f32x4 acc2 = (f32x4){0.f, 0.f, 0.f, 0.f};
#pragma unroll
                for (int j = 0; j < 8; j += 2) { acc = MFMA16(cvt4(S[j]), Bq[j], acc); acc2 = MFMA16(cvt4(S[j + 1]), Bq[j + 1], acc2); }
                acc2 = MFMA16(Vt, Pt, acc2);
                acc = acc + acc2;
                { u32x2 pk2; pk2.x = pg8::cvt_pk_bf16(acc[0], acc[1]); pk2.y = pg8::cvt_pk_bf16(acc[2], acc[3]);
                  *(u32x2*)((char*)(so + ((size_t)dir * T + chunk_row0(b, dir, c)) * D + 1024 + h * 128 + 16 * wave) + (size_t)(unsigned)((rix(dir, 16 * sub + l15) * D + 4 * g) * 2)) = pk2; }
#pragma unroll
                for (int j = 0; j < 8; ++j) S[j] = MFMA16(Ak[j], Vt, S[j] * gsv[j]);
            }
            __syncthreads();
        }
#undef HGRN_LOAD
    }
}

__device__ __forceinline__ void phase_out_even(int wv, const bf16* u, const bf16* so, const float* dskip, const float* ssd_nw, const float* hgrn_nw, bf16* y, int row_lo) {
    const int tid = opaque_tid(wv), lane = tid & 63, wave = wv;
    const int gw = blockIdx.x * 8 + wave, nwv = gridDim.x * 8;
    for (int row = row_lo + gw; row < T; row += nwv) {
        const bf16* ur = u + (size_t)row * EV_MAIN; const bf16* sr = so + (size_t)row * D; const bf16* sr2 = so + ((size_t)T + row) * D;
        u32x4 rxs[2], rz[2], rg[2], rsa[4], rsb[4]; f32x4 nwa[4][2];
#pragma unroll
        for (int j = 0; j < 2; ++j) { const int c = j * 512 + lane * 8; rxs[j] = *(const u32x4*)(ur + EU_XBC + c); rz[j] = *(const u32x4*)(ur + EU_Z + c); rg[j] = *(const u32x4*)(ur + EU_G + c);
            nwa[j][0] = *(const f32x4*)(ssd_nw + c); nwa[j][1] = *(const f32x4*)(ssd_nw + c + 4); nwa[2 + j][0] = *(const f32x4*)(hgrn_nw + c); nwa[2 + j][1] = *(const f32x4*)(hgrn_nw + c + 4); }
#pragma unroll
        for (int j = 0; j < 4; ++j) { const int c = j * 512 + lane * 8; rsa[j] = *(const u32x4*)(sr + c); rsb[j] = *(const u32x4*)(sr2 + c); }
#pragma unroll
        for (int j = 0; j < 2; ++j) {
            const int c = j * 512 + lane * 8;
            float xs[8], z[8], val[8], sa[8], sb[8]; unpack8(rxs[j], xs); unpack8(rz[j], z); unpack8(rsa[j], sa); unpack8(rsb[j], sb);
            const float dsk = dskip[c >> 6]; float ss = 0.f;
#pragma unroll
            for (int i = 0; i < 8; ++i) { const float yy = (sa[i] + sb[i]) + xs[i] * dsk; val[i] = yy * silu_(z[i]); ss += val[i] * val[i]; }
            ss = wave_sum(ss, lane);
            const float rs = rsqrtf(ss * (1.f / 512.f) + EPS);
#pragma unroll
            for (int i = 0; i < 8; ++i) val[i] = val[i] * rs * (i < 4 ? nwa[j][0][i] : nwa[j][1][i - 4]);
            *(u32x4*)(y + pg8::tiled_off((size_t)row, c, D)) = pack8(val);
        }
#pragma unroll
        for (int j = 0; j < 2; ++j) {
            const int c = j * 512 + lane * 8;
            float gg[8], val[8], sa[8], sb[8]; unpack8(rg[j], gg); unpack8(rsa[2 + j], sa); unpack8(rsb[2 + j], sb);
            float ss = 0.f;
#pragma unroll
            for (int i = 0; i < 8; ++i) { val[i] = sa[i] + sb[i]; ss += val[i] * val[i]; }
            ss += shx(ss, 1, lane); ss += shx(ss, 2, lane); ss += shx(ss, 4, lane); ss += shx(ss, 8, lane);
            const float rs = rsqrtf(ss * (1.f / 128.f) + EPS);
#pragma unroll
            for (int i = 0; i < 8; ++i) val[i] = val[i] * rs * (i < 4 ? nwa[2 + j][0][i] : nwa[2 + j][1][i - 4]) * silu_(gg[i]);
            *(u32x4*)(y + pg8::tiled_off((size_t)row, 1024 + c, D)) = pack8(val);
        }
    }
}
__device__ __forceinline__ void phase_out_odd(int wv, const bf16* u, const bf16* so, const float* nw, bf16* y, int row_lo) {
    const int tid = opaque_tid(wv), lane = tid & 63, wave = wv;
    const int gw = blockIdx.x * 8 + wave, nwv = gridDim.x * 8;
    for (int row = row_lo + gw; row < T; row += nwv) {
        const bf16* ur = u + (size_t)row * OD_MAIN; const bf16* sr = so + (size_t)row * D; const bf16* sr2 = so + ((size_t)T + row) * D;
        u32x4 rog[4], rsa[4], rsb[4]; f32x4 nwa[4][2];
#pragma unroll
        for (int j = 0; j < 4; ++j) { const int c = j * 512 + lane * 8; rog[j] = *(const u32x4*)(ur + OU_O + c); rsa[j] = *(const u32x4*)(sr + c); rsb[j] = *(const u32x4*)(sr2 + c);
            nwa[j][0] = *(const f32x4*)(nw + c); nwa[j][1] = *(const f32x4*)(nw + c + 4); }
#pragma unroll
        for (int j = 0; j < 4; ++j) {
            const int c = j * 512 + lane * 8;
            float og[8], val[8], sa[8], sb[8]; unpack8(rog[j], og); unpack8(rsa[j], sa); unpack8(rsb[j], sb);
            float ss = 0.f;
#pragma unroll
            for (int i = 0; i < 8; ++i) { val[i] = sa[i] + sb[i]; ss += val[i] * val[i]; }
            ss = wave_sum(ss, lane);
            const float rs = rsqrtf(ss * (1.f / 512.f) + EPS);
#pragma unroll
            for (int i = 0; i < 8; ++i) val[i] = val[i] * rs * (i < 4 ? nwa[j][0][i] : nwa[j][1][i - 4]) * sigmoid_(og[i]);
            *(u32x4*)(y + pg8::tiled_off((size_t)row, c, D)) = pack8(val);
        }
    }
}

__device__ __forceinline__ float dpp_ror1(float v) { return __int_as_float(__builtin_amdgcn_update_dpp(0, __float_as_int(v), 0x121, 0xf, 0xf, false)); }
__device__ __forceinline__ float dpp_rol1(float v) { return __int_as_float(__builtin_amdgcn_update_dpp(0, __float_as_int(v), 0x12f, 0xf, 0xf, false)); }
struct EpiU {
    static constexpr bool PERM = true, AFTER_DRAIN = false;
    bf16* U; int ldu; int n_main; float* gates;
    const float* cw; const float* cb; int cv_lo, cv_hi, nch, ks_pn; LASP unsigned char* lds;
    __device__ __forceinline__ void operator()(const f32x4 (&acc)[2][2][4][2], const pg8::Unit& u, int wr, int wc, int fr, int fq) const {
        int row0 = u.pm * 256 + wr * 64 + fr; asm volatile("" : "+v"(row0));
        if (u.pn < n_main) {
            const int col0 = u.pn * 256 + wc * 32 + 8 * fq;
            if (u.pn < cv_lo || u.pn >= cv_hi) {
#pragma unroll
                for (int ai = 0; ai < 2; ++ai)
#pragma unroll
                    for (int m = 0; m < 4; ++m) { bf16* rowp = U + (size_t)(row0 + ai * 128 + m * 16) * ldu + col0;
#pragma unroll
                        for (int bj = 0; bj < 2; ++bj) { const f32x4 v0 = acc[ai][bj][m][0], v1 = acc[ai][bj][m][1];
                            u32x4 w; w.x = pg8::cvt_pk_bf16(v0[0], v0[1]); w.y = pg8::cvt_pk_bf16(v0[2], v0[3]); w.z = pg8::cvt_pk_bf16(v1[0], v1[1]); w.w = pg8::cvt_pk_bf16(v1[2], v1[3]);
                            *(u32x4*)(rowp + bj * 128) = w; } }
            } else {
                const bool ctx = u.pm < 16; const float post = u.pn >= ks_pn ? 0.0625f : 1.f;
                const int lc0 = wc * 32 + 8 * fq, ch0 = (u.pn - cv_lo) * 256 + lc0;
                LASP float* EX = (LASP float*)(lds + 131072);
                if (ctx) {
#pragma unroll
                    for (int ai = 0; ai < 2; ++ai) { const int k = ai * 2 + wr;
#pragma unroll
                        for (int bj = 0; bj < 2; ++bj)
#pragma unroll
                            for (int n = 0; n < 2; ++n) {
                                if (fr == 0) *(LASP f32x4*)(EX + (k * 2 + 0) * 256 + bj * 128 + lc0 + 4 * n) = acc[ai][bj][0][n];
                                if (fr == 15) *(LASP f32x4*)(EX + (k * 2 + 1) * 256 + bj * 128 + lc0 + 4 * n) = acc[ai][bj][3][n]; } }
                    asm volatile("s_waitcnt lgkmcnt(0)" ::: "memory"); __builtin_amdgcn_s_barrier(); asm volatile("" ::: "memory");
                }
#pragma unroll
                for (int bj = 0; bj < 2; ++bj) {
                    f32x4 w0[2], w1[2], w2[2], bb[2];
#pragma unroll
                    for (int n = 0; n < 2; ++n) { const int ch = ch0 + bj * 128 + 4 * n;
                        w0[n] = *(const f32x4*)(cw + ch); w1[n] = *(const f32x4*)(cw + nch + ch); w2[n] = *(const f32x4*)(cw + 2 * nch + ch); bb[n] = *(const f32x4*)(cb + ch); }
#pragma unroll
                    for (int ai = 0; ai < 2; ++ai) { const int k = ai * 2 + wr;
                        f32x4 bprev[2], bnext[2];
#pragma unroll
                        for (int n = 0; n < 2; ++n) { bprev[n] = (f32x4){0.f, 0.f, 0.f, 0.f}; bnext[n] = (f32x4){0.f, 0.f, 0.f, 0.f};
                            if (ctx) { if (k > 0) bprev[n] = *(const LASP f32x4*)(EX + ((k - 1) * 2 + 1) * 256 + bj * 128 + lc0 + 4 * n);
                                       if (k < 3) bnext[n] = *(const LASP f32x4*)(EX + ((k + 1) * 2 + 0) * 256 + bj * 128 + lc0 + 4 * n); } }
#pragma unroll
                        for (int m = 0; m < 4; ++m) { float o[2][4];
#pragma unroll
                            for (int n = 0; n < 2; ++n)
#pragma unroll
                                for (int i = 0; i < 4; ++i) {
                                    const float rs_ = dpp_ror1(acc[ai][bj][m][n][i]), rp_ = m > 0 ? dpp_ror1(acc[ai][bj][m > 0 ? m - 1 : 0][n][i]) : bprev[n][i];
                                    const float ls_ = dpp_rol1(acc[ai][bj][m][n][i]), ln_ = m < 3 ? dpp_rol1(acc[ai][bj][m < 3 ? m + 1 : 3][n][i]) : bnext[n][i];
                                    const float pv = fr == 0 ? rp_ : rs_, nx = fr == 15 ? ln_ : ls_;
                                    const float a = bb[n][i] + w0[n][i] * pv + w1[n][i] * acc[ai][bj][m][n][i] + w2[n][i] * nx;
                                    o[n][i] = a * __builtin_amdgcn_rcpf(1.f + __expf(-a)) * post; }
                            u32x4 w; w.x = pg8::cvt_pk_bf16(o[0][0], o[0][1]); w.y = pg8::cvt_pk_bf16(o[0][2], o[0][3]); w.z = pg8::cvt_pk_bf16(o[1][0], o[1][1]); w.w = pg8::cvt_pk_bf16(o[1][2], o[1][3]);
                            *(u32x4*)(U + (size_t)(row0 + ai * 128 + m * 16) * ldu + col0 + bj * 128) = w; } } }
            }
        } else if (wc == 0) {
#pragma unroll
            for (int ai = 0; ai < 2; ++ai)
#pragma unroll
                for (int m = 0; m < 4; ++m) { float* gp = gates + (size_t)(row0 + ai * 128 + m * 16) * 32 + 8 * fq;
                    *(f32x4*)gp = acc[ai][0][m][0]; *(f32x4*)(gp + 4) = acc[ai][0][m][1]; }
        }
    }
};
struct EpiAct {
    static constexpr bool PERM = true, AFTER_DRAIN = false;
    bf16* O; int ldc;
    __device__ __forceinline__ void operator()(const f32x4 (&acc)[2][2][4][2], const pg8::Unit& u, int wr, int wc, int fr, int fq) const {
        int row0 = u.pm * 256 + wr * 64 + fr; asm volatile("" : "+v"(row0)); const int col0 = u.pn * 256 + wc * 32 + 8 * fq;
#pragma unroll
        for (int ai = 0; ai < 2; ++ai)
#pragma unroll
            for (int m = 0; m < 4; ++m) { bf16* rowp = O + pg8::tiled_off((size_t)(row0 + ai * 128 + m * 16), col0, ldc);
#pragma unroll
                for (int bj = 0; bj < 2; ++bj) { f32x4 v0 = acc[ai][bj][m][0], v1 = acc[ai][bj][m][1];
#pragma unroll
                    for (int i = 0; i < 4; ++i) { const float a = fmaxf(v0[i], 0.f), b = fmaxf(v1[i], 0.f); v0[i] = a * a; v1[i] = b * b; }
                    u32x4 w; w.x = pg8::cvt_pk_bf16(v0[0], v0[1]); w.y = pg8::cvt_pk_bf16(v0[2], v0[3]); w.z = pg8::cvt_pk_bf16(v1[0], v1[1]); w.w = pg8::cvt_pk_bf16(v1[2], v1[3]);
                    *(u32x4*)(rowp + bj * (2 * 256 * 64)) = w; } }
    }
};
struct EpiRes {
    static constexpr bool PERM = true, AFTER_DRAIN = false;
    const void* xc_in; bf16* xc_out; const void* xl_in; bf16* xl_out; int in_f32; const float* gate_base; int pm_off; float* pb;
    __device__ __forceinline__ void operator()(const f32x4 (&acc)[2][2][4][2], const pg8::Unit& u, int wr, int wc, int fr, int fq) const {
        const int pmg = u.pm + pm_off;
        const void* rin; bf16* rout; int gr; size_t rbase;
        if (pmg < 16) { rin = xc_in; rout = xc_out; rbase = (size_t)pmg * 256; gr = 16; }
        else { rin = xl_in; rout = xl_out; rbase = (size_t)(pmg - 16) * 256; gr = (pmg - 16) >> 3; }
        const float* gate = gate_base + (size_t)gr * MODW;
        int row0 = wr * 64 + fr; asm volatile("" : "+v"(row0)); const int col0 = u.pn * 256 + wc * 32 + 8 * fq;
        f32x4 gv[2][2];
#pragma unroll
        for (int bj = 0; bj < 2; ++bj)
#pragma unroll
            for (int n = 0; n < 2; ++n) gv[bj][n] = *(const f32x4*)(gate + col0 + bj * 128 + n * 4);
        if (u.part == 2) {
            float* po = pb + (size_t)pmg * 256 * D;
#pragma unroll
            for (int ai = 0; ai < 2; ++ai)
#pragma unroll
                for (int m = 0; m < 4; ++m) { const size_t off = (size_t)(row0 + ai * 128 + m * 16) * D + col0;
#pragma unroll
                    for (int bj = 0; bj < 2; ++bj)
#pragma unroll
                        for (int n = 0; n < 2; ++n) *(f32x4*)(po + off + bj * 128 + n * 4) = gv[bj][n] * acc[ai][bj][m][n]; }
            return;
        }
        if (in_f32) {
#pragma unroll
            for (int ai = 0; ai < 2; ++ai)
#pragma unroll
                for (int m = 0; m < 4; ++m) { const size_t off = (rbase + row0 + ai * 128 + m * 16) * D + col0; float r[2][8];
#pragma unroll
                    for (int bj = 0; bj < 2; ++bj) load_x8(rin, true, off + bj * 128, r[bj]);
#pragma unroll
                    for (int bj = 0; bj < 2; ++bj) {
#pragma unroll
                        for (int i = 0; i < 4; ++i) { r[bj][i] += gv[bj][0][i] * acc[ai][bj][m][0][i]; r[bj][4 + i] += gv[bj][1][i] * acc[ai][bj][m][1][i]; }
                        *(u32x4*)(rout + off + bj * 128) = pack8(r[bj]); } }
        } else {
            u32x4 xr[2][4][2];
#pragma unroll
            for (int ai = 0; ai < 2; ++ai)
#pragma unroll
                for (int m = 0; m < 4; ++m)
#pragma unroll
                    for (int bj = 0; bj < 2; ++bj) xr[ai][m][bj] = *(const u32x4*)((const bf16*)rin + (rbase + row0 + ai * 128 + m * 16) * D + col0 + bj * 128);
#pragma unroll
            for (int ai = 0; ai < 2; ++ai)
#pragma unroll
                for (int m = 0; m < 4; ++m) { const size_t off = (rbase + row0 + ai * 128 + m * 16) * D + col0;
#pragma unroll
                    for (int bj = 0; bj < 2; ++bj) { float r[8]; unpack8(xr[ai][m][bj], r);
#pragma unroll
                        for (int i = 0; i < 4; ++i) { r[i] += gv[bj][0][i] * acc[ai][bj][m][0][i]; r[4 + i] += gv[bj][1][i] * acc[ai][bj][m][1][i]; }
                        *(u32x4*)(rout + off + bj * 128) = pack8(r); } }
        }
    }
};

constexpr int NPH = 1 + 9 * DEPTH + 1;

__device__ __forceinline__ int opaque_gdim() { int g = (int)gridDim.x; asm volatile("" : "+s"(g)); return g; }
__global__ void __launch_bounds__(512, 2) fwd_kernel(Params p) {
    extern __shared__ __attribute__((aligned(16))) unsigned char lds_raw[];
    LASP unsigned char* lds = (LASP unsigned char*)lds_raw;
    int wv = __builtin_amdgcn_readfirstlane((int)(threadIdx.x >> 6)); asm volatile("" : "+s"(wv));
    const int tid = opaque_tid(wv);
    unsigned char* ws = p.ws;
#if ONE_LAUNCH
    constexpr int lo = 0, hi = NPH;
#else
    const int lo = p.ph_lo, hi = p.ph_hi;
#endif
    const bool multi = (hi - lo) > 1;
    XcdBarrier bar; bar.bar = (unsigned*)(ws + WS_CTL) + CW_BAR; bar.x = 0; bar.st = nullptr; bar.wv = wv;
    if (multi) {
        if (tid < 4) ((LASP unsigned*)(lds + LDS_BARW))[tid] = 0u;
        __syncthreads();
        bar = xcd_barrier_post((unsigned*)(ws + WS_CTL) + CW_BAR, (volatile LASP unsigned*)(lds + LDS_BARW), wv);
    }
#define IN(k) (lo <= (k) && (k) < hi)
#define SEAM(k) do { if ((k) + 1 < hi) { bar.x = xb_xcc_id(); xcd_barrier(bar); } } while (0)

    float* mod = (float*)(ws + WS_MOD);
    float* gates = (float*)(ws + WS_GATES);
    bf16* xc = (bf16*)(ws + WS_XC);
    bf16* xl = (bf16*)(ws + WS_XL);
    bf16* hbuf = (bf16*)(ws + WS_H);
    bf16* ubuf = (bf16*)(ws + WS_U);
#define split_ok (opaque_gdim() == 256)
    float* pbuf = (float*)(ws + WS_SO);
    bf16* so = (bf16*)(ws + WS_SO);
    unsigned char* wl = ws + WS_WT;
    const bf16* w_in = (const bf16*)wl; const bf16* w_out = (const bf16*)(wl + WT_IN_E);
    const bf16* w1 = (const bf16*)(wl + WT_IN_E + WT_OUT); const bf16* w2 = (const bf16*)(wl + WT_IN_E + WT_OUT + WT_W1);
    LASP float* tile = (LASP float*)lds;
#define CONVERT_LAYER(l_) do { const int e_ = (l_) >> 1; \
        if (((l_) & 1) == 0) { convert_wt(wv, pin(p, I_EWIN) + (size_t)e_ * D * EVEN_IN, D, EVEN_IN, EVEN_IN, (bf16*)wl, EV_PAD, 1, tile); \
                               convert_wt(wv, pin(p, I_EWOUT) + (size_t)e_ * D * D, D, D, D, (bf16*)(wl + WT_IN_E), D, 0, tile); } \
        else { convert_wt(wv, pin(p, I_OWIN) + (size_t)e_ * D * ODD_IN, D, ODD_IN, ODD_IN, (bf16*)wl, OD_PAD, 0, tile); \
               convert_wt(wv, pin(p, I_OWOUT) + (size_t)e_ * D * D, D, D, D, (bf16*)(wl + WT_IN_E), D, 0, tile); } \
        convert_wt(wv, pin(p, I_W1) + (size_t)(l_) * D * DFF, D, DFF, DFF, (bf16*)(wl + WT_IN_E + WT_OUT), DFF, 0, tile); \
        convert_wt(wv, pin(p, I_W2) + (size_t)(l_) * DFF * D, DFF, D, D, (bf16*)(wl + WT_IN_E + WT_OUT + WT_W1), D, 0, tile); } while (0)

    if (IN(0)) {
        CONVERT_LAYER(0);
        __syncthreads();
        phase_mod(wv, p, lds);
        SEAM(0);
    }

    for (int l = 0; l < DEPTH; ++l) {
        const int pb = 1 + 9 * l, e = l >> 1;
        const bool odd = (l & 1) != 0, last = (l == DEPTH - 1), first = (l == 0);
        const float* modl = mod + (size_t)l * 17 * MODW;
        const void* xc_cur = first ? (const void*)pin(p, I_CTX) : (const void*)xc;
        const void* xl_cur = first ? (const void*)pin(p, I_X) : (const void*)xl;
        const int ldu = odd ? OD_MAIN : EV_MAIN;
        const int row_lo2 = last ? TC : 0;

        if (IN(pb + 0)) {
            phase_norm(wv, xc_cur, xl_cur, first, pin(p, I_NORMW) + (size_t)(l * 2 + 0) * D, modl, 1, 0, hbuf, 0, (!first && split_ok) ? pbuf : (const float*)nullptr, xc, lds);
            if (!first) CONVERT_LAYER(l);
            SEAM(pb + 0);
        }
        if (IN(pb + 1)) {
            const int npad = odd ? OD_PAD : EV_PAD;
            pg8::Gemm g{hbuf, w_in, T, npad, D}; pg8::InOrder S; S.init(npad, D, gridDim.x, blockIdx.x, 4, OU_O / 256, last ? (OU_O + 2048) / 256 : OU_O / 256);
            EpiU E{ubuf, ldu, (odd ? OD_MAIN : EV_MAIN) / 256, gates,
                   odd ? pin(p, I_MCONVW) + (size_t)e * 3 * 2048 : pin(p, I_SCONVW) + (size_t)e * 3 * 1536, odd ? pin(p, I_MCONVB) + (size_t)e * 2048 : pin(p, I_SCONVB) + (size_t)e * 1536,
                   odd ? 0 : EU_XBC / 256, odd ? 8 : (EU_XBC + 1536) / 256, odd ? 2048 : 1536, odd ? 4 : 1000, lds};
            pg8::gemm_phase<EpiU, pg8::InOrder, true, true>(wv, lds, g, S, E);
            SEAM(pb + 1);
        }
        if (IN(pb + 3)) {
            if (!odd) {
                phase_ssd_chunk(wv, ubuf, gates, pin(p, I_ALOG) + e * 32, pin(p, I_DTB) + e * 32, so, lds); __syncthreads();
                phase_hgrn_chunk(wv, ubuf, pin(p, I_HLB), e, so, lds);
            } else {
                phase_mlstm_chunk(wv, ubuf, gates, pin(p, I_MGATEB) + e * 16, so, lds);
            }
            SEAM(pb + 3);
        }
        if (IN(pb + 4)) {
            if (!odd) phase_out_even(wv, ubuf, so, pin(p, I_SSDD) + e * 16, pin(p, I_SSDNW) + e * 1024, pin(p, I_HNW) + e * 1024, hbuf, row_lo2);
            else phase_out_odd(wv, ubuf, so, pin(p, I_MNW) + (size_t)e * D, hbuf, row_lo2);
            SEAM(pb + 4);
        }
        if (IN(pb + 5)) {
            const int M = T - row_lo2;
            pg8::Gemm g{hbuf, w_out, M, D, D}; pg8::ResOrder S; S.init(D, D, gridDim.x, blockIdx.x, last ? 0 : 1, 4);
            EpiRes E{xc_cur, xc, xl_cur, xl, first ? 1 : 0, modl + 2 * D, 0, pbuf};
            pg8::gemm_phase<EpiRes, pg8::ResOrder, true, true>(wv, lds, g, S, E);
            SEAM(pb + 5);
        }
        if (IN(pb + 6)) { phase_norm(wv, xc, xl, false, pin(p, I_NORMW) + (size_t)(l * 2 + 1) * D, modl, 4, 3, hbuf, row_lo2, (last || !split_ok) ? (const float*)nullptr : pbuf, xc, lds); SEAM(pb + 6); }
        if (IN(pb + 7)) {
            const int M = T - row_lo2;
            pg8::Gemm g{hbuf + (size_t)row_lo2 * D, w1, M, DFF, D}; pg8::StaticOrder S; S.init(M, DFF, D, gridDim.x, blockIdx.x, 4);
            EpiAct E{ubuf + (size_t)row_lo2 * DFF, DFF};
            pg8::gemm_phase<EpiAct, pg8::StaticOrder, true, true>(wv, lds, g, S, E);
            SEAM(pb + 7);
        }
        if (IN(pb + 8)) {
            const int M = T - row_lo2;
            pg8::Gemm g{ubuf, w2, M, D, DFF}; pg8::ResOrder S; S.init(D, DFF, gridDim.x, blockIdx.x, last ? 0 : 1, 4);
            EpiRes E{xc, xc, xl, xl, 0, modl + 5 * D, 0, pbuf};
            pg8::gemm_phase<EpiRes, pg8::ResOrder, true, true>(wv, lds, g, S, E);
            SEAM(pb + 8);
        }
    }
#undef CONVERT_LAYER
    if (IN(NPH - 1)) phase_final_norm(wv, xl, p.out, pin(p, I_FNORMW));
#undef IN
#undef SEAM
}

extern "C" void kernel_launch(void* const* d_in, const int* in_sizes, int n_in, void* d_out, int out_size, void* d_ws, size_t ws_size, hipStream_t stream) {
    static int grid = 0;
    if (grid == 0) {
        if (n_in != 26 || out_size != TL * D || ws_size < WS_END) { fprintf(stderr, "kernel_launch: unexpected shapes (n_in %d out %d ws %zu need %zu)\n", n_in, out_size, ws_size, (size_t)WS_END); grid = -1; return; }
        int dev = 0, cus = 0;
        if (hipGetDevice(&dev) != hipSuccess || hipDeviceGetAttribute(&cus, hipDeviceAttributeMultiprocessorCount, dev) != hipSuccess) { grid = -1; return; }
        if (hipFuncSetAttribute((const void*)fwd_kernel, hipFuncAttributeMaxDynamicSharedMemorySize, LDS_BYTES) != hipSuccess) { fprintf(stderr, "kernel_launch: hipFuncSetAttribute failed\n"); grid = -1; return; }
        int per_cu = 0;
        if (hipOccupancyMaxActiveBlocksPerMultiprocessor(&per_cu, (const void*)fwd_kernel, 512, LDS_BYTES) != hipSuccess || per_cu < 1) { fprintf(stderr, "kernel_launch: occupancy query says %d\n", per_cu); }
        (void)hipGetLastError();
        grid = cus;
    }
    if (grid < 0) return;
    (void)hipMemsetAsync((char*)d_ws + WS_CTL, 0, CTL_BYTES, stream);
    Params p{};
    for (int i = 0; i < 26; ++i) p.in[i] = (const float*)d_in[i];
    p.out = (float*)d_out; p.ws = (unsigned char*)d_ws;
#if ONE_LAUNCH
    p.ph_lo = 0; p.ph_hi = NPH;
    hipLaunchKernelGGL(fwd_kernel, dim3(grid), dim3(512), LDS_BYTES, stream, p);
#else
    for (int k = 0; k < NPH; ++k) { p.ph_lo = k; p.ph_hi = k + 1; hipLaunchKernelGGL(fwd_kernel, dim3(grid), dim3(512), LDS_BYTES, stream, p); }
#endif
}
```

```cpp
#include <hip/hip_runtime.h>
#include <cstdio>
#include <cstdint>
#ifndef ONE_LAUNCH
#define ONE_LAUNCH 0
#endif
#undef ONE_LAUNCH
#define ONE_LAUNCH 1
__device__ __forceinline__ int opaque_tid(int wv) { unsigned z = 0u; asm volatile("" : "+v"(z)); const int l = (int)__builtin_amdgcn_mbcnt_hi(~0u, __builtin_amdgcn_mbcnt_lo(~0u, z)); return (wv << 6) | l; }
namespace pg8 {
#define PG8_LAS __attribute__((address_space(3)))
typedef unsigned short bf16_t;
typedef short bf16x8 __attribute__((ext_vector_type(8)));
typedef float f32x4 __attribute__((ext_vector_type(4)));
typedef unsigned u32x4 __attribute__((ext_vector_type(4)));
constexpr int BM = 256, BK = 64, HALF = 128, HTB = HALF * BK * 2  , STAGE_BYTES = 8 * HTB, NXCD = 8, WGM = 8;

__host__ __device__ __forceinline__ int lds_byte(int r, int c) { const int st = (r >> 4) * 2 + (c >> 5), rr = r & 15, cc = c & 31, ob = rr * 64 + cc * 2; return st * 1024 + (ob ^ (((ob >> 9) & 1) << 5)); }
__host__ __device__ __forceinline__ void stage_rc(int b, int& R, int& C) { const int st = b / 1024, sb = b % 1024, swz = sb ^ (((sb >> 9) & 1) << 5); R = (st >> 1) * 16 + swz / 64; C = (st & 1) * 32 + (swz % 64) / 2; }
__host__ __device__ __forceinline__ int perm32(int rho) { const int n = rho >> 4, i = rho & 15; return 8 * (i >> 2) + 4 * n + (i & 3); }

__host__ __device__ __forceinline__ int perm32_inv(int cidx) { return ((cidx >> 2) & 1) * 16 + ((cidx >> 3) << 2) + (cidx & 3); }
__host__ __device__ __forceinline__ size_t tiled_off(size_t row, int col, int K, bool perm = false) {
    int r = (int)(row & 127); if (perm) r = (r & ~31) + perm32_inv(r & 31);
    return ((row >> 8) * (size_t)(K / BK) + (size_t)(col >> 6)) * (size_t)(BM * BK) + ((row >> 7) & 1) * (size_t)(HALF * BK) + (size_t)(lds_byte(r, col & 63) >> 1);
}
struct Unit { int pm, pn, kt0, nkt, part; };
struct Gemm { const bf16_t* A; const bf16_t* Bt; int M, N, K; };

struct StaticOrder {
    int nM, nN, nwg, G, c, nkt, wgm;
    __host__ __device__ void init(int M, int N, int K, int G_, int c_, int wgm_ = WGM) { nM = M / BM; nN = N / BM; nwg = nM * nN; G = G_; c = c_; nkt = K / BK; wgm = wgm_; }
    __host__ __device__ bool next(int i, Unit& u) const {
        const long L = (long)i * G + c; if (L >= nwg) return false;
        u.kt0 = 0; u.nkt = nkt; u.part = 0;
        int wgid = (int)L; { const int q = nwg / NXCD, r = nwg % NXCD, xcd = wgid % NXCD, off = wgid / NXCD; wgid = (xcd < r ? xcd * (q + 1) : r * (q + 1) + (xcd - r) * q) + off; }
        const int nig = wgm * nN, gid = wgid / nig, fm = gid * wgm, gsz = (nM - fm) < wgm ? (nM - fm) : wgm;
        u.pm = fm + ((wgid % nig) % gsz); u.pn = (wgid % nig) / gsz; return true;
    }
    __device__ __forceinline__ void a_ready(const Unit&) const {}
    __device__ __forceinline__ void done(const Unit&) const {}
};

struct ResOrder {
    StaticOrder lat; int ctx, nkt, c, G;
    __host__ __device__ void init(int N, int K, int G_, int c_, int with_ctx, int wgm_ = WGM) { lat.init(32768, N, K, G_, c_, wgm_); ctx = with_ctx; nkt = K / BK; c = c_; G = G_; }
    __host__ __device__ bool next(int i, Unit& u) const {
        if (lat.next(i, u)) { u.pm += 16; return true; }
        if (!ctx) return false;
        const int r0 = (lat.nwg + G - 1) / G;
        if (G == 256) {
            if (i != r0) return false;
            const int j = c & 127; u.pm = j & 15; u.pn = j >> 4; u.part = 1 + (c >> 7); u.nkt = nkt / 2; u.kt0 = (c >> 7) * (nkt / 2); return true;
        }
        const long j = (long)(i - r0) * G + c; if (i < r0 || j >= 128) return false;
        u.pm = (int)(j & 15); u.pn = (int)(j >> 4); u.part = 0; u.nkt = nkt; u.kt0 = 0; return true;
    }
    __device__ __forceinline__ void a_ready(const Unit&) const {}
    __device__ __forceinline__ void done(const Unit&) const {}
};

struct InOrder {
    StaticOrder lat; int nN, G, c, nkt, skip_lo, skip_n;
    __host__ __device__ void init(int N, int K, int G_, int c_, int wgm_, int skip_lo_, int skip_hi_) { lat.init(32768, N, K, G_, c_, wgm_); nN = N / BM; G = G_; c = c_; nkt = K / BK; skip_lo = skip_lo_; skip_n = skip_hi_ - skip_lo_; }
    __host__ __device__ bool next(int i, Unit& u) const {
        if (lat.next(i, u)) { u.pm += 16; return true; }
        const long j = (long)i * G + c - lat.nwg; if (j < 0 || j >= 16L * (nN - skip_n)) return false;
        const int q = (int)(j >> 4); u.pm = (int)(j & 15); u.pn = q < skip_lo ? q : q + skip_n; u.kt0 = 0; u.nkt = nkt; u.part = 0; return true;
    }
    __device__ __forceinline__ void a_ready(const Unit&) const {}
    __device__ __forceinline__ void done(const Unit&) const {}
};

typedef __bf16 nbf16x2 __attribute__((ext_vector_type(2))); typedef float nf32x2 __attribute__((ext_vector_type(2)));
__device__ __forceinline__ unsigned cvt_pk_bf16(float lo, float hi) { const nf32x2 f = {lo, hi}; return __builtin_bit_cast(unsigned, __builtin_convertvector(f, nbf16x2)); }
typedef float f32x2 __attribute__((ext_vector_type(2)));
template <class Epi, class Sched, bool ALIGN_EPI = false, bool SP2 = false>
__device__ __forceinline__ void gemm_phase(int wv, PG8_LAS unsigned char* lds, const Gemm g, const Sched& S, const Epi& E) {
    const int tid = opaque_tid(wv), wid = __builtin_amdgcn_readfirstlane(tid >> 6), lane = tid & 63, wr = wid >> 2, wc = wid & 3, fr = lane & 15, fq = lane >> 4;
    const int K = g.K;
    unsigned voffA[2], voffB[2];
#pragma unroll
    for (int i = 0; i < 2; ++i) { voffA[i] = (unsigned)(tid * 16 + i * 8192); voffB[i] = voffA[i]; }
    const size_t kstep = (size_t)(BM * BK * 2);
    const size_t hstep = (size_t)HALF * BK * 2;
    const size_t tstep = (size_t)(K / BK) * kstep;
    const unsigned ldsw = (unsigned)wid * 1024u;
    const int aoff = lds_byte(wr * 64 + fr, fq * 8), boff = lds_byte(wc * 32 + fr, fq * 8);
#define PG8_SA(b, h) (((b) * 2 + (h)) * HTB)
#define PG8_SB(b, h) ((4 + (b) * 2 + (h)) * HTB)
#define PG8_STAGE(bufoff, gbase, voff) do { _Pragma("unroll") for (int _i = 0; _i < 2; ++_i) \
        __builtin_amdgcn_global_load_lds((const unsigned*)((const char*)(gbase) + (voff)[_i]), (PG8_LAS unsigned*)(lds + (bufoff) + ldsw + _i * 8192), 16, 0, 0); } while (0)
#define PG8_LDA(dst, b, h) do { _Pragma("unroll") for (int m = 0; m < 4; ++m) _Pragma("unroll") for (int k = 0; k < 2; ++k) dst[m][k] = *(const PG8_LAS bf16x8*)(lds + PG8_SA(b, h) + aoff + m * 2048 + k * 1024); } while (0)
#define PG8_LDB(dst, b, h) do { _Pragma("unroll") for (int n = 0; n < 2; ++n) _Pragma("unroll") for (int k = 0; k < 2; ++k) dst[n][k] = *(const PG8_LAS bf16x8*)(lds + PG8_SB(b, h) + boff + n * 2048 + k * 1024); } while (0)
#define PG8_MMA(ai, bj, At, Bt) do { __builtin_amdgcn_s_setprio(1); _Pragma("unroll") for (int m = 0; m < 4; ++m) _Pragma("unroll") for (int n = 0; n < 2; ++n) _Pragma("unroll") for (int k = 0; k < 2; ++k) \
        acc[ai][bj][m][n] = __builtin_amdgcn_mfma_f32_16x16x32_bf16(Bt[n][k], At[m][k], acc[ai][bj][m][n], 0, 0, 0); __builtin_amdgcn_s_setprio(0); } while (0)
#define PG8_WAIT_V(n) asm volatile("s_waitcnt vmcnt(" #n ")" ::: "memory")
#define PG8_WAIT_L(n) asm volatile("s_waitcnt lgkmcnt(" #n ")" ::: "memory")
#define PG8_BAR __builtin_amdgcn_s_barrier()
#define PG8_SCHED __builtin_amdgcn_sched_barrier(0)
    Unit cur, nxt; int ui = 0;
    if (!S.next(0, cur)) return;
    f32x4 acc[2][2][4][2];
#pragma unroll
    for (int a = 0; a < 2; ++a)
#pragma unroll
        for (int b = 0; b < 2; ++b)
#pragma unroll
            for (int m = 0; m < 4; ++m)
#pragma unroll
                for (int n = 0; n < 2; ++n) acc[a][b][m][n] = (f32x4){0.f, 0.f, 0.f, 0.f};
    bf16x8 At[4][2], B0[2][2], B1[2][2];
    const char* cA = (const char*)g.A + (size_t)cur.pm * tstep + (size_t)cur.kt0 * kstep; const char* cB = (const char*)g.Bt + (size_t)cur.pn * tstep + (size_t)cur.kt0 * kstep;
    S.a_ready(cur);
    if constexpr (SP2) {
        PG8_STAGE(PG8_SB(0, 0), cB, voffB); PG8_STAGE(PG8_SB(0, 1), cB + hstep, voffB); PG8_STAGE(PG8_SA(0, 0), cA, voffA); PG8_STAGE(PG8_SA(0, 1), cA + hstep, voffA);
        if (wr == 1) PG8_BAR;
        PG8_WAIT_V(2); PG8_BAR;
        PG8_STAGE(PG8_SB(1, 0), cB + kstep, voffB); PG8_STAGE(PG8_SA(1, 0), cA + kstep, voffA); PG8_STAGE(PG8_SB(1, 1), cB + hstep + kstep, voffB);
        PG8_WAIT_V(6); PG8_BAR;
    } else {
        PG8_STAGE(PG8_SB(0, 0), cB, voffB); PG8_STAGE(PG8_SA(0, 0), cA, voffA); PG8_STAGE(PG8_SB(0, 1), cB + hstep, voffB); PG8_STAGE(PG8_SA(0, 1), cA + hstep, voffA);
        if (wr == 1) PG8_BAR;
        PG8_WAIT_V(4); PG8_BAR;
        PG8_STAGE(PG8_SB(1, 0), cB + kstep, voffB); PG8_STAGE(PG8_SA(1, 0), cA + kstep, voffA); PG8_STAGE(PG8_SB(1, 1), cB + hstep + kstep, voffB);
        PG8_WAIT_V(6); PG8_BAR;
    }
    for (;;) {
        const bool has_next = S.next(ui + 1, nxt);
        const char* nA = has_next ? (const char*)g.A + (size_t)nxt.pm * tstep + (size_t)nxt.kt0 * kstep : cA; const char* nB = has_next ? (const char*)g.Bt + (size_t)nxt.pn * tstep + (size_t)nxt.kt0 * kstep : cB;
        const int nt = cur.nkt;
        for (int t = 0; t < nt; t += 2) {
            const bool last = (t == nt - 2);
            const char* a1 = cA + (size_t)(t + 1) * kstep;
            const char* a2 = last ? nA : cA + (size_t)(t + 2) * kstep; const char* b2 = last ? nB : cB + (size_t)(t + 2) * kstep;
            const char* a3 = a2 + kstep; const char* b3 = b2 + kstep;
            if (last && has_next) S.a_ready(nxt);
            if constexpr (SP2) {
            PG8_LDB(B0, 0, 0); PG8_LDB(B1, 0, 1); PG8_SCHED; PG8_LDA(At, 0, 0); PG8_STAGE(PG8_SA(1, 1), a1 + hstep, voffA);
            PG8_WAIT_V(8); PG8_WAIT_L(0); PG8_BAR; PG8_MMA(0, 0, At, B0); PG8_MMA(0, 1, At, B1); PG8_BAR; PG8_SCHED;
            PG8_LDA(At, 0, 1); PG8_STAGE(PG8_SB(0, 0), b2, voffB); PG8_STAGE(PG8_SB(0, 1), b2 + hstep, voffB); PG8_STAGE(PG8_SA(0, 0), a2, voffA);
            PG8_WAIT_V(8); PG8_WAIT_L(0); PG8_BAR; PG8_MMA(1, 0, At, B0); PG8_MMA(1, 1, At, B1); PG8_BAR; PG8_SCHED;
            PG8_LDB(B0, 1, 0); PG8_LDB(B1, 1, 1); PG8_SCHED; PG8_LDA(At, 1, 0); PG8_STAGE(PG8_SA(0, 1), a2 + hstep, voffA);
            PG8_WAIT_V(8); PG8_WAIT_L(0); PG8_BAR; PG8_MMA(0, 0, At, B0); PG8_MMA(0, 1, At, B1); PG8_BAR; PG8_SCHED;
            PG8_LDA(At, 1, 1); PG8_STAGE(PG8_SB(1, 0), b3, voffB); PG8_STAGE(PG8_SB(1, 1), b3 + hstep, voffB); PG8_STAGE(PG8_SA(1, 0), a3, voffA);
            PG8_WAIT_V(8); PG8_WAIT_L(0); PG8_BAR; PG8_MMA(1, 0, At, B0); PG8_MMA(1, 1, At, B1); PG8_BAR; PG8_SCHED;
            } else {
            PG8_LDB(B0, 0, 0); PG8_SCHED; PG8_LDA(At, 0, 0); PG8_STAGE(PG8_SA(1, 1), a1 + hstep, voffA);
            PG8_WAIT_L(8); PG8_BAR; PG8_WAIT_L(0); PG8_MMA(0, 0, At, B0); PG8_BAR; PG8_SCHED;
            PG8_LDB(B1, 0, 1); PG8_STAGE(PG8_SB(0, 0), b2, voffB);
            PG8_BAR; PG8_WAIT_L(0); PG8_MMA(0, 1, At, B1); PG8_BAR;
            PG8_LDA(At, 0, 1); PG8_STAGE(PG8_SA(0, 0), a2, voffA);
            PG8_BAR; PG8_WAIT_L(0); PG8_MMA(1, 0, At, B0); PG8_BAR; PG8_SCHED;
            PG8_STAGE(PG8_SB(0, 1), b2 + hstep, voffB);
            PG8_WAIT_V(6); PG8_BAR; PG8_MMA(1, 1, At, B1); PG8_BAR;
            PG8_LDB(B0, 1, 0); PG8_SCHED; PG8_LDA(At, 1, 0); PG8_STAGE(PG8_SA(0, 1), a2 + hstep, voffA);
            PG8_WAIT_L(8); PG8_BAR; PG8_WAIT_L(0); PG8_MMA(0, 0, At, B0); PG8_BAR; PG8_SCHED;
            PG8_LDB(B1, 1, 1); PG8_STAGE(PG8_SB(1, 0), b3, voffB);
            PG8_BAR; PG8_WAIT_L(0); PG8_MMA(0, 1, At, B1); PG8_BAR;
            PG8_LDA(At, 1, 1); PG8_STAGE(PG8_SA(1, 0), a3, voffA);
            PG8_BAR; PG8_WAIT_L(0); PG8_MMA(1, 0, At, B0); PG8_BAR; PG8_SCHED;
            PG8_STAGE(PG8_SB(1, 1), b3 + hstep, voffB);
            PG8_WAIT_V(6); PG8_BAR; PG8_MMA(1, 1, At, B1); PG8_BAR;
            }
        }
        if constexpr (ALIGN_EPI) { if (wr == 0) PG8_BAR; }
        if constexpr (!Epi::AFTER_DRAIN) { E(acc, cur, wr, wc, fr, fq); S.done(cur); }
        if (!has_next) break;
#pragma unroll
        for (int a = 0; a < 2; ++a)
#pragma unroll
            for (int b = 0; b < 2; ++b)
#pragma unroll
                for (int m = 0; m < 4; ++m)
#pragma unroll
                    for (int n = 0; n < 2; ++n) acc[a][b][m][n] = (f32x4){0.f, 0.f, 0.f, 0.f};
        cur = nxt; cA = nA; cB = nB; ++ui;
        if constexpr (ALIGN_EPI) { if (wr == 1) PG8_BAR; }
    }
    PG8_WAIT_V(0);
    if constexpr (!ALIGN_EPI) { if (wr == 0) PG8_BAR; }
    PG8_BAR;
    if constexpr (Epi::AFTER_DRAIN) { E.fused(acc, cur, wr, wc, fr, fq, lds, wid, lane); S.done(cur); }
#undef PG8_SA
#undef PG8_SB
#undef PG8_STAGE
#undef PG8_LDA
#undef PG8_LDB
#undef PG8_MMA
#undef PG8_WAIT_V
#undef PG8_WAIT_L
#undef PG8_BAR
#undef PG8_SCHED
}
}

#define XB_TMO      128
#define XB_XCNT(j)  (256  + 64 * (j))
#define XB_XSUB(j)  (1280 + 64 * (j))
#define XB_XGEN(j)  (2304 + 64 * (j))
#define XB_TOP      3328
#define XB_TOPGEN   3392
#define XCD_BAR_WORDS 3456
#define XB_SPIN_CAP (1u << 18)
#define LAS __attribute__((address_space(3)))

__device__ __forceinline__ unsigned xb_ld(unsigned* p)              { return __hip_atomic_load(p, __ATOMIC_RELAXED, __HIP_MEMORY_SCOPE_AGENT); }
__device__ __forceinline__ unsigned xb_add(unsigned* p, unsigned v) { return __hip_atomic_fetch_add(p, v, __ATOMIC_RELAXED, __HIP_MEMORY_SCOPE_AGENT); }
__device__ __forceinline__ unsigned xb_xcc_id() { return (unsigned)__builtin_amdgcn_s_getreg((3 << 11) | 20) & 0xFu; }
#define XB_SPIN(cond, bar) do { unsigned _sp = 0; while (cond) { __builtin_amdgcn_s_sleep(1); \
    if ((++_sp & 255u) == 0u) { if (xb_ld(&(bar)[XB_TMO])) break; if (_sp > XB_SPIN_CAP) { atomicAdd(&(bar)[XB_TMO], 1u); break; } } } } while (0)

struct XcdBarrier {
    unsigned* bar; unsigned x; int wv;
    volatile LAS unsigned* st;
};

__device__ __forceinline__ XcdBarrier xcd_barrier_post(unsigned* bar, volatile LAS unsigned* st, int wv) {
    XcdBarrier b; b.bar = bar; b.x = xb_xcc_id(); b.st = st; b.wv = wv;
    if (opaque_tid(wv) == 0) (void)xb_add(&bar[XB_XCNT(b.x)], 1u);
    return b;
}
__device__ __forceinline__ void xcd_barrier_complete(unsigned* bar, unsigned x, unsigned& nloc, unsigned& nx) {
    const unsigned G = gridDim.x * gridDim.y * gridDim.z;
    unsigned sum, cnt, mine, sp = 0u;
    for (;;) {
        sum = 0u; cnt = 0u; mine = 0u;
#pragma unroll
        for (unsigned j = 0; j < 16; ++j) { const unsigned c = xb_ld(&bar[XB_XCNT(j)]); sum += c; cnt += (c > 0u) ? 1u : 0u; mine = (j == x) ? c : mine; }
        if (sum == G) break;
        __builtin_amdgcn_s_sleep(1);
        if ((++sp & 255u) == 0u) { if (xb_ld(&bar[XB_TMO])) break; if (sp > XB_SPIN_CAP) { atomicAdd(&bar[XB_TMO], 1u); break; } }
    }
    nloc = mine > 0u ? mine : 1u; nx = cnt > 0u ? cnt : 1u;
}

__device__ __forceinline__ void xcd_barrier(const XcdBarrier& b) {
    asm volatile("s_waitcnt vmcnt(0)" ::: "memory");
    __syncthreads();
    if (opaque_tid(b.wv) == 0) {
        unsigned* bar = b.bar;
        __builtin_amdgcn_s_waitcnt(0);
        unsigned nloc = b.st[0], nx = b.st[1];
        if (nloc == 0u) { xcd_barrier_complete(bar, b.x, nloc, nx); b.st[0] = nloc; b.st[1] = nx; }
        const unsigned old = xb_add(&bar[XB_XSUB(b.x)], 1u);
        const unsigned gen = old / nloc;
        if (old + 1u == (gen + 1u) * nloc) {
            __builtin_amdgcn_fence(__ATOMIC_RELEASE, "agent");
            asm volatile("s_waitcnt vmcnt(0)" ::: "memory");
            const unsigned og = xb_add(&bar[XB_TOP], 1u);
            const unsigned tg = og / nx;
            if (og + 1u == (tg + 1u) * nx) xb_add(&bar[XB_TOPGEN], 1u);
            else XB_SPIN(xb_ld(&bar[XB_TOPGEN]) == tg, bar);
            __builtin_amdgcn_fence(__ATOMIC_ACQUIRE, "agent");
            xb_add(&bar[XB_XGEN(b.x)], 1u);
            asm volatile("s_waitcnt vmcnt(0)" ::: "memory");
        } else {
            XB_SPIN(xb_ld(&bar[XB_XGEN(b.x)]) == gen, bar);
            __builtin_amdgcn_fence(__ATOMIC_ACQUIRE, "agent");
            asm volatile("s_waitcnt vmcnt(0)" ::: "memory");
        }
    }
    __syncthreads();
}


#define LASP __attribute__((address_space(3)))
typedef unsigned short bf16;
typedef pg8::f32x4 f32x4;
typedef pg8::u32x4 u32x4;
typedef unsigned u32x2 __attribute__((ext_vector_type(2)));
typedef float f32x2 __attribute__((ext_vector_type(2)));
constexpr int D = 2048, BATCH = 16, SEQ = 2048, CTX = 256, DEPTH = 4, DFF = 8192;
constexpr int TC = BATCH * CTX, TL = BATCH * SEQ, T = TC + TL;
constexpr int MODW = 6 * D;
constexpr int EVEN_IN = 7712, ODD_IN = 6160;
constexpr int EV_MAIN = 7680, EV_PAD = 7936, OD_MAIN = 6144, OD_PAD = 6400;
constexpr int EU_Z = 0, EU_XBC = 1024, EU_Q = 2560, EU_F = 3584, EU_I = 5632, EU_G = 6656;
constexpr int OU_QK = 0, OU_V = 2048, OU_O = 4096;
constexpr float EPS = 1e-6f;

constexpr size_t MiB = 1u << 20;
constexpr size_t WS_CTL = 0, CTL_BYTES = 64 * 1024;
constexpr size_t WS_MOD = 1 * MiB;
constexpr size_t WS_GATES = 5 * MiB;
constexpr size_t WS_XC = 10 * MiB;
constexpr size_t WS_XL = 42 * MiB;
constexpr size_t WS_WT = 170 * MiB;
constexpr size_t WT_IN_E = (size_t)EV_PAD * D * 2, WT_IN_O = (size_t)OD_PAD * D * 2, WT_OUT = (size_t)D * D * 2, WT_W1 = (size_t)DFF * D * 2, WT_W2 = (size_t)D * DFF * 2;
constexpr size_t WT_LAYER = 104 * MiB;
constexpr size_t WS_H = WS_WT + WT_LAYER;
constexpr size_t WS_U = WS_H + (size_t)T * D * 2;
constexpr size_t WS_SO = WS_U + (size_t)T * DFF * 2;
constexpr size_t WS_END = WS_SO + (size_t)T * D * 4;
static_assert(WT_IN_E + WT_OUT + WT_W1 + WT_W2 <= WT_LAYER, "weights per layer");
static_assert(WS_END <= (size_t)1536 * MiB && WS_XL + (size_t)TL * D * 2 <= WS_WT, "workspace");
constexpr int CW_BAR = 4096;

constexpr int LDS_BYTES = 147456;
constexpr int LDS_BARW = LDS_BYTES - 64;

struct Params { const float* in[26]; float* out; unsigned char* ws; int ph_lo, ph_hi; };
enum { I_X = 0, I_C, I_CTX, I_CCTX, I_MODW, I_MODB, I_NORMW, I_FNORMW, I_W1, I_W2, I_EWIN, I_EWOUT, I_SCONVW, I_SCONVB, I_ALOG, I_DTB, I_SSDD, I_SSDNW, I_HLB, I_HNW, I_OWIN, I_OWOUT, I_MCONVW, I_MCONVB, I_MGATEB, I_MNW };

__device__ __forceinline__ const float* pin(const Params& p, int i) { asm volatile("" : "+s"(i)); return p.in[i]; }
__device__ __forceinline__ float bf2f(bf16 h) { return __uint_as_float((unsigned)h << 16); }
__device__ __forceinline__ float bf_lo(unsigned w) { return __uint_as_float(w << 16); }
__device__ __forceinline__ float bf_hi(unsigned w) { return __uint_as_float(w & 0xffff0000u); }
__device__ __forceinline__ void unpack8(const u32x4 w, float (&f)[8]) { f[0] = bf_lo(w.x); f[1] = bf_hi(w.x); f[2] = bf_lo(w.y); f[3] = bf_hi(w.y); f[4] = bf_lo(w.z); f[5] = bf_hi(w.z); f[6] = bf_lo(w.w); f[7] = bf_hi(w.w); }
__device__ __forceinline__ u32x4 pack8(const float (&f)[8]) { u32x4 w; w.x = pg8::cvt_pk_bf16(f[0], f[1]); w.y = pg8::cvt_pk_bf16(f[2], f[3]); w.z = pg8::cvt_pk_bf16(f[4], f[5]); w.w = pg8::cvt_pk_bf16(f[6], f[7]); return w; }
__device__ __forceinline__ float sigmoid_(float x) { return 1.f / (1.f + __expf(-x)); }
__device__ __forceinline__ float silu_(float x) { return x / (1.f + __expf(-x)); }
__device__ __forceinline__ float log1p_pos(float y) { return y < 0.0078125f ? y * (1.f - y * (0.5f - y * 0.33333334f)) : __logf(1.f + y); }
__device__ __forceinline__ float softplus_(float x) { return x > 20.f ? x : log1p_pos(__expf(x)); }
__device__ __forceinline__ float shx(float v, int m, int lane) { return __int_as_float(__builtin_amdgcn_ds_bpermute((lane ^ m) << 2, __float_as_int(v))); }
__device__ __forceinline__ float shup(float v, int o, int lane) { return __int_as_float(__builtin_amdgcn_ds_bpermute((lane - o) << 2, __float_as_int(v))); }
__device__ __forceinline__ float rdlane(float v, int l) { return __int_as_float(__builtin_amdgcn_readlane(__float_as_int(v), l)); }
__device__ __forceinline__ float wave_sum(float v, int lane) {
#pragma unroll
    for (int o = 32; o > 0; o >>= 1) v += shx(v, o, lane);
    return v;
}
__device__ __forceinline__ int seq_row(int b, int dir, int s) {
    if (s < CTX) return b * CTX + (dir ? (CTX - 1 - s) : s);
    const int j = s - CTX; return TC + b * SEQ + (dir ? (SEQ - 1 - j) : j);
}

__device__ __forceinline__ int chunk_row0(int b, int dir, int c) {
    if (c < CTX / 64) return b * CTX + (dir ? CTX - 64 - c * 64 : c * 64);
    const int j0 = (c - CTX / 64) * 64; return TC + b * SEQ + (dir ? SEQ - 64 - j0 : j0);
}
__device__ __forceinline__ int rix(int dir, int s) { return dir ? 63 - s : s; }

__device__ __forceinline__ int wt_map(int n, int mode, int Nsrc) {
    if (mode == 0) return n < Nsrc ? n : -1;
    if (n < 2560) return n;
    if (n < EV_MAIN) return n + 32;
    if (n < EV_MAIN + 32) return 2560 + (n - EV_MAIN);
    return -1;
}
__device__ __forceinline__ void convert_wt(int wv, const float* src, int K, int ldsrc, int Nsrc, bf16* dst, int Npad, int mode, LASP float* tile) {
    const int tid = opaque_tid(wv), nkt = K / 64, nnt = Npad / 64, ntiles = nkt * nnt;
    for (int it0 = blockIdx.x; it0 < ntiles; it0 += 4 * gridDim.x) {
        f32x4 v[4][2];
#pragma unroll
        for (int q = 0; q < 4; ++q) { const int it = it0 + q * gridDim.x; const bool live = it < ntiles; const int itc = live ? it : it0;
            const int ntl = itc % nnt, kt = itc / nnt, k0 = kt * 64, n0 = ntl * 64;
#pragma unroll
            for (int i = 0; i < 2; ++i) { const int e = tid + i * 512, kk = e >> 4, n4 = (e & 15) * 4, sc = wt_map(n0 + n4, mode, Nsrc);
                v[q][i] = (f32x4){0.f, 0.f, 0.f, 0.f};
                if (sc >= 0) v[q][i] = *(const f32x4*)(src + (size_t)(k0 + kk) * ldsrc + sc); } }
#pragma unroll
        for (int q = 0; q < 4; ++q) { LASP float* tl = tile + q * (64 * 65);
#pragma unroll
            for (int i = 0; i < 2; ++i) { const int e = tid + i * 512, kk = e >> 4, n4 = (e & 15) * 4;
                tl[kk * 65 + n4 + 0] = v[q][i][0]; tl[kk * 65 + n4 + 1] = v[q][i][1]; tl[kk * 65 + n4 + 2] = v[q][i][2]; tl[kk * 65 + n4 + 3] = v[q][i][3]; } }
        __syncthreads();
#pragma unroll
        for (int q = 0; q < 4; ++q) { const int it = it0 + q * gridDim.x; if (it >= ntiles) break;
            const int ntl = it % nnt, kt = it / nnt, k0 = kt * 64, n0 = ntl * 64; LASP float* tl = tile + q * (64 * 65);
            const int n = tid >> 3, k8 = (tid & 7) * 8; float f[8];
#pragma unroll
            for (int j = 0; j < 8; ++j) f[j] = tl[(k8 + j) * 65 + n];
            *(u32x4*)(dst + pg8::tiled_off((size_t)(n0 + n), k0 + k8, K, true)) = pack8(f); }
        __syncthreads();
    }
}

__device__ __forceinline__ void phase_mod(int wv, const Params& p, LASP unsigned char* lds) {
    const int tid = opaque_tid(wv), lane = tid & 63, wave = wv;
    LASP float* s = (LASP float*)lds;
    LASP float* red = (LASP float*)(lds + 17 * 2048 * 4);
    const float* c = pin(p, I_C); const float* cc = pin(p, I_CCTX);
    for (int i = tid; i < 17 * 2048; i += 512) { const float v = i < 16 * 2048 ? c[i] : cc[i - 16 * 2048]; s[i] = silu_(v); }
    __syncthreads();
    const float* mw = pin(p, I_MODW); const float* mb = pin(p, I_MODB); float* mod = (float*)(p.ws + WS_MOD);
    for (int unit = blockIdx.x; unit < 4 * 192; unit += gridDim.x) {
        const int l = unit / 192, cg = unit % 192, col = cg * 64 + lane;
        for (int i = tid; i < 17 * 64; i += 512) red[i] = 0.f;
        __syncthreads();
        float acc[17];
#pragma unroll
        for (int r = 0; r < 17; ++r) acc[r] = 0.f;
        const float* wp = mw + ((size_t)l * 2048 + wave * 256) * MODW + col;
#pragma unroll 2
        for (int k = 0; k < 256; k += 4) {
            const float w0 = wp[(size_t)(k + 0) * MODW], w1 = wp[(size_t)(k + 1) * MODW], w2 = wp[(size_t)(k + 2) * MODW], w3 = wp[(size_t)(k + 3) * MODW];
#pragma unroll
            for (int r = 0; r < 17; ++r) { const f32x4 sv = *(const LASP f32x4*)(s + r * 2048 + wave * 256 + k); acc[r] += sv[0] * w0 + sv[1] * w1 + sv[2] * w2 + sv[3] * w3; }
        }
        for (int w = 0; w < 8; ++w) {
            if (wave == w) {
#pragma unroll
                for (int r = 0; r < 17; ++r) red[r * 64 + lane] += acc[r];
            }
            __syncthreads();
        }
        for (int i = tid; i < 17 * 64; i += 512) { const int r = i >> 6, cl = i & 63; mod[((size_t)l * 17 + r) * MODW + cg * 64 + cl] = red[i] + mb[(size_t)l * MODW + cg * 64 + cl]; }
        __syncthreads();
    }
}

__device__ __forceinline__ void load_x8(const void* base, bool is_f32, size_t eoff, float (&v)[8]) {
    if (is_f32) { const f32x4 a = *(const f32x4*)((const float*)base + eoff), b = *(const f32x4*)((const float*)base + eoff + 4);
        v[0] = a[0]; v[1] = a[1]; v[2] = a[2]; v[3] = a[3]; v[4] = b[0]; v[5] = b[1]; v[6] = b[2]; v[7] = b[3]; }
    else unpack8(*(const u32x4*)((const bf16*)base + eoff), v);
}
__device__ __forceinline__ void norm_load_pair(const void* xc_src, const void* xl_src, bool src_f32, int row, int lane, float (&va)[4][8], float (&vb)[4][8]) {
    const void* base = row < TC ? xc_src : xl_src; const int rr = row < TC ? row : row - TC;
#pragma unroll
    for (int j = 0; j < 4; ++j) { const int k = j * 512 + lane * 8;
        load_x8(base, src_f32, (size_t)rr * D + k, va[j]); load_x8(base, src_f32, (size_t)(rr + 1) * D + k, vb[j]); }
}
__device__ __forceinline__ void phase_norm(int wv, const void* xc_src, const void* xl_src, bool src_f32, const float* nw, const float* modl, int isc, int ish, bf16* h, int row_lo, const float* pb, bf16* xc_wb, LASP unsigned char* lds) {
    const int tid = opaque_tid(wv), lane = tid & 63;
    LASP float* cs = (LASP float*)lds;
    LASP float* ss = cs + 2048;
    int vp0 = blockIdx.x; asm volatile("" : "+s"(vp0));
#pragma unroll 1
    for (int vp = vp0; vp < 512; vp += gridDim.x) {
        const int part = vp >> 8, vb = vp & 255;
        const int lo = part == 0 ? row_lo : (row_lo > TC ? row_lo : TC), hi = part == 0 ? TC : T;
        if (lo >= hi) continue;
        const int per = (((hi - lo) / 2 + 255) >> 8) * 2;
        int r0 = lo + vb * per; const int r1 = r0 + per < hi ? r0 + per : hi;
        while (r0 < r1) {
            const int mr = r0 < TC ? 16 : (r0 - TC) / SEQ;
            const int seg_end = r0 < TC ? TC : TC + (mr + 1) * SEQ;
            const int re = r1 < seg_end ? r1 : seg_end;
            __syncthreads();
            { const int k = tid * 4; const float* sc = modl + (size_t)mr * MODW + isc * D; const float* sh = modl + (size_t)mr * MODW + ish * D;
              const f32x4 w4 = *(const f32x4*)(nw + k), s4 = *(const f32x4*)(sc + k), h4 = *(const f32x4*)(sh + k); f32x4 c4;
#pragma unroll
              for (int i = 0; i < 4; ++i) c4[i] = w4[i] * (s4[i] + 1.f);
              const int sl = ((((k >> 9) * 2 + ((k >> 2) & 1)) * 64) + ((k >> 3) & 63)) * 4;
              *(LASP f32x4*)(cs + sl) = c4; *(LASP f32x4*)(ss + sl) = h4; }
            __syncthreads();
            float va[4][8], vb[4][8];
            int row = r0 + 2 * wv;
            if (row < re) norm_load_pair(xc_src, xl_src, src_f32, row, lane, va, vb);
            for (; row < re; row += 16) {
                float na[4][8], nb[4][8];
                if (row + 16 < re) norm_load_pair(xc_src, xl_src, src_f32, row + 16, lane, na, nb);
                __builtin_amdgcn_sched_barrier(0);
                const int rowb = row + 1;
                if (pb != nullptr && row < TC) {
#pragma unroll
                    for (int j = 0; j < 4; ++j) { const int k = j * 512 + lane * 8;
                        const f32x4 p0 = *(const f32x4*)(pb + (size_t)row * D + k), p1 = *(const f32x4*)(pb + (size_t)row * D + k + 4), q0 = *(const f32x4*)(pb + (size_t)rowb * D + k), q1 = *(const f32x4*)(pb + (size_t)rowb * D + k + 4);
#pragma unroll
                        for (int i = 0; i < 4; ++i) { va[j][i] += p0[i]; va[j][4 + i] += p1[i]; vb[j][i] += q0[i]; vb[j][4 + i] += q1[i]; }
                        *(u32x4*)(xc_wb + (size_t)row * D + k) = pack8(va[j]); *(u32x4*)(xc_wb + (size_t)rowb * D + k) = pack8(vb[j]); }
                }
                float sa = 0.f, sb = 0.f;
#pragma unroll
                for (int j = 0; j < 4; ++j)
#pragma unroll
                    for (int i = 0; i < 8; ++i) { sa += va[j][i] * va[j][i]; sb += vb[j][i] * vb[j][i]; }
#pragma unroll
                for (int o = 32; o > 0; o >>= 1) { sa += shx(sa, o, lane); sb += shx(sb, o, lane); }
                const float ra = rsqrtf(sa * (1.f / D) + EPS), rbs = rsqrtf(sb * (1.f / D) + EPS);
#pragma unroll
                for (int j = 0; j < 4; ++j) { const int k = j * 512 + lane * 8; float oa[8], ob[8];
                    const f32x4 c0 = *(const LASP f32x4*)(cs + ((j * 2 + 0) * 64 + lane) * 4), c1 = *(const LASP f32x4*)(cs + ((j * 2 + 1) * 64 + lane) * 4);
                    const f32x4 h0 = *(const LASP f32x4*)(ss + ((j * 2 + 0) * 64 + lane) * 4), h1 = *(const LASP f32x4*)(ss + ((j * 2 + 1) * 64 + lane) * 4);
#pragma unroll
                    for (int i = 0; i < 4; ++i) {
                        oa[i] = va[j][i] * ra * c0[i] + h0[i]; oa[4 + i] = va[j][4 + i] * ra * c1[i] + h1[i];
                        ob[i] = vb[j][i] * rbs * c0[i] + h0[i]; ob[4 + i] = vb[j][4 + i] * rbs * c1[i] + h1[i]; }
                    *(u32x4*)(h + pg8::tiled_off((size_t)row, k, D)) = pack8(oa); *(u32x4*)(h + pg8::tiled_off((size_t)rowb, k, D)) = pack8(ob); }
                __builtin_amdgcn_sched_barrier(0);
#pragma unroll
                for (int j = 0; j < 4; ++j)
#pragma unroll
                    for (int i = 0; i < 8; ++i) { va[j][i] = na[j][i]; vb[j][i] = nb[j][i]; }
            }
            r0 = re;
        }
    }
    __syncthreads();
}
__device__ __forceinline__ void phase_final_norm(int wv, const bf16* x, float* out, const float* nw) {
    const int tid = opaque_tid(wv), lane = tid & 63, wave = wv;
    const int gw = blockIdx.x * 8 + wave, nwv = gridDim.x * 8;
    for (int row = gw; row < TL; row += nwv) {
        float v[4][8]; float ss = 0.f;
#pragma unroll
        for (int j = 0; j < 4; ++j) unpack8(*(const u32x4*)(x + (size_t)row * D + j * 512 + lane * 8), v[j]);
#pragma unroll
        for (int j = 0; j < 4; ++j)
#pragma unroll
            for (int i = 0; i < 8; ++i) ss += v[j][i] * v[j][i];
        ss = wave_sum(ss, lane);
        const float rs = rsqrtf(ss * (1.f / D) + EPS);
#pragma unroll
        for (int j = 0; j < 4; ++j) { const int k = j * 512 + lane * 8; const f32x4 w0 = *(const f32x4*)(nw + k), w1 = *(const f32x4*)(nw + k + 4); f32x4 o0, o1;
#pragma unroll
            for (int i = 0; i < 4; ++i) { o0[i] = v[j][i] * rs * w0[i]; o1[i] = v[j][4 + i] * rs * w1[i]; }
            *(f32x4*)(out + (size_t)row * D + k) = o0; *(f32x4*)(out + (size_t)row * D + k + 4) = o1; }
    }
}

typedef short s16x4 __attribute__((ext_vector_type(4)));
typedef short s16x8 __attribute__((ext_vector_type(8)));
__device__ __forceinline__ s16x4 tr_read4(LASP const unsigned char* p) { return __builtin_amdgcn_ds_read_tr16_b64_v4i16((LASP s16x4*)p); }
__device__ __forceinline__ s16x4 cvt4(const f32x4 v) { u32x2 r; r.x = pg8::cvt_pk_bf16(v[0], v[1]); r.y = pg8::cvt_pk_bf16(v[2], v[3]); return __builtin_bit_cast(s16x4, r); }
__device__ __forceinline__ float logsigmoid_(float x) { return fminf(x, 0.f) - log1p_pos(__expf(-fabsf(x))); }
#define MFMA16(a, b, c) __builtin_amdgcn_mfma_f32_16x16x16bf16_1k((a), (b), (c), 0, 0, 0)
#define MFMA32(a, b, c) __builtin_amdgcn_mfma_f32_16x16x32_bf16((a), (b), (c), 0, 0, 0)

__device__ __forceinline__ void phase_mlstm_chunk(int wv, const bf16* u, const float* gates, const float* gate_b, bf16* so, LASP unsigned char* lds) {
    constexpr int L = 64, NC = (CTX + SEQ) / L, RSQ = 528, RSK = 544, RSV = 288, RSP = 144;
    constexpr int OFF_Q = 0, OFF_K = OFF_Q + L * RSQ, OFF_V = OFF_K + L * RSK, OFF_V2 = OFF_V + L * RSV, OFF_P = OFF_V2 + L * RSV, OFF_F = OFF_P + L * RSP;
    const int tid = opaque_tid(wv), lane = tid & 63, wave = wv, g = lane >> 4, l15 = lane & 15;
    LASP float* fb = (LASP float*)(lds + OFF_F);
    LASP float* s_gv = fb;
    LASP float* s_misc = fb + 512;
    LASP float* s_denp = fb + 520; LASP float* s_qn = fb + 776; LASP float* s_n = fb + 840;
    LASP bf16* s_wb = (LASP bf16*)(fb + 1864);
    for (int item = blockIdx.x; item < BATCH * 4 * 2 * 4; item += gridDim.x) {
        const int b = item >> 5, h = (item >> 3) & 3, dir = (item >> 2) & 1, vq = item & 3;
        const float bi = gate_b[dir * 4 + h], bfg = gate_b[(2 + dir) * 4 + h];
        f32x4 S[16];
#pragma unroll
        for (int j = 0; j < 16; ++j) S[j] = (f32x4){0.f, 0.f, 0.f, 0.f};
        s_n[opaque_tid(wv)] = 0.f;
        f32x4 Nn[2] = {(f32x4){0.f, 0.f, 0.f, 0.f}, (f32x4){0.f, 0.f, 0.f, 0.f}};
        u32x4 pq[4], pk[4], pv[2]; float gi = 0.f, gf = 0.f;
        const int dsq = (dir ? -16 : 16) * OD_MAIN * 2, dsv = (dir ? -32 : 32) * OD_MAIN * 2;
#define MLSTM_LOAD(c) do { const char* ub_ = (const char*)u + (size_t)chunk_row0(b, dir, (c)) * (OD_MAIN * 2); const int t_ = opaque_tid(wv);     \
            const unsigned voq = (unsigned)((rix(dir, t_ >> 5) * OD_MAIN + OU_QK + h * 256 + (t_ & 31) * 8) * 2), vov = (unsigned)((rix(dir, t_ >> 4) * OD_MAIN + OU_V + h * 512 + vq * 128 + (t_ & 15) * 8) * 2); \
            _Pragma("unroll") for (int i = 0; i < 4; ++i) { const char* uq_ = ub_ + (size_t)(unsigned)(voq + i * dsq); pq[i] = *(const u32x4*)uq_; pk[i] = *(const u32x4*)(uq_ + 2048); } \
            _Pragma("unroll") for (int i = 0; i < 2; ++i) pv[i] = *(const u32x4*)(ub_ + (size_t)(unsigned)(vov + i * dsv)); } while (0)
#define MLSTM_GLOAD(c) do { const float* gb_ = gates + (size_t)chunk_row0(b, dir, (c)) * 32 + dir * 4 + h; gi = gb_[rix(dir, lane) * 32]; gf = gb_[rix(dir, lane) * 32 + 8]; } while (0)
#define MLSTM_GPREP(par) do { const float li_ = gi + bi; float x_ = logsigmoid_(gf + bfg); \
            _Pragma("unroll") for (int o = 1; o < 64; o <<= 1) { const float y_ = shup(x_, o, lane); if (lane >= o) x_ += y_; } \
            const float btot_ = rdlane(x_, 63); LASP float* gp_ = s_gv + (par) * 256; \
            const float w_ = __expf(btot_ - x_ + li_); gp_[lane] = x_; gp_[64 + lane] = li_; gp_[128 + lane] = w_; gp_[192 + lane] = __expf(x_); \
            s_wb[(par) * 64 + lane] = (bf16)(pg8::cvt_pk_bf16(w_, 0.f) & 0xffffu); \
            if (lane == 0) s_misc[par] = __expf(btot_); } while (0)
        MLSTM_LOAD(0);
        if (wave == 0) { MLSTM_GLOAD(0); MLSTM_GPREP(0); MLSTM_GLOAD(1); }
        for (int c = 0; c < NC; ++c) {
            const int par = c & 1;
            LASP float* s_b = s_gv + par * 256; LASP float* s_li = s_b + 64; LASP float* s_w = s_b + 128; LASP float* s_eb = s_b + 192;
            LASP float* n_cur = s_n + par * 256; LASP float* n_nxt = s_n + (par ^ 1) * 256;
#pragma unroll
            for (int i = 0; i < 4; ++i) { const int idx = tid + i * 512, r = idx >> 5, pc = idx & 31; *(LASP u32x4*)(lds + OFF_Q + r * RSQ + pc * 16) = pq[i]; *(LASP u32x4*)(lds + OFF_K + r * RSK + pc * 16) = pk[i]; }
#pragma unroll
            for (int i = 0; i < 2; ++i) { const int idx = tid + i * 512, r = idx >> 4, pc = idx & 15; *(LASP u32x4*)(lds + OFF_V + r * RSV + pc * 16) = pv[i]; }
            __syncthreads();
#pragma unroll
            for (int i = 0; i < 2; ++i) { const int idx = tid + i * 512, r = idx >> 4, pc = idx & 15; float v8[8]; unpack8(pv[i], v8); const float w = s_w[r];
#pragma unroll
                for (int j = 0; j < 8; ++j) v8[j] *= w;
                *(LASP u32x4*)(lds + OFF_V2 + r * RSV + pc * 16) = pack8(v8); }
            if (c + 1 < NC) MLSTM_LOAD(c + 1);
            if (wave < 6) {
                const int tb = wave == 0 ? 0 : wave == 1 ? 1 : wave < 4 ? 2 : 3, sb0 = (wave == 3 || wave == 5) ? 2 : 0, ntl = (wave == 0 || wave == 3) ? 1 : 2;
                f32x4 ag0 = (f32x4){0.f, 0.f, 0.f, 0.f}, ag1 = (f32x4){0.f, 0.f, 0.f, 0.f};
#pragma unroll
                for (int kh = 0; kh < 2; ++kh) { s16x8 Gb[4], Ga0[4], Ga1[4];
#pragma unroll
                  for (int ks = 0; ks < 4; ++ks) { Gb[ks] = *(const LASP s16x8*)(lds + OFF_Q + (16 * tb + l15) * RSQ + (kh * 4 + ks) * 64 + g * 16);
                      Ga0[ks] = *(const LASP s16x8*)(lds + OFF_K + (16 * sb0 + l15) * RSK + (kh * 4 + ks) * 64 + g * 16);
                      Ga1[ks] = *(const LASP s16x8*)(lds + OFF_K + (16 * (sb0 + ntl - 1) + l15) * RSK + (kh * 4 + ks) * 64 + g * 16); }
                  __builtin_amdgcn_sched_barrier(0);
#pragma unroll
                  for (int ks = 0; ks < 4; ++ks) { ag0 = MFMA32(Ga0[ks], Gb[ks], ag0); ag1 = MFMA32(Ga1[ks], Gb[ks], ag1); } }
                const int t = 16 * tb + l15; const float bt = s_b[t];
#pragma unroll
                for (int q = 0; q < 2; ++q) { if (q >= ntl) break; const int sb = sb0 + q; const f32x4 ag = q == 0 ? ag0 : ag1; float pvv[4], rs = 0.f;
#pragma unroll
                    for (int i = 0; i < 4; ++i) { const int sidx = 16 * sb + 4 * g + i; pvv[i] = sidx <= t ? ag[i] * __expf(bt - s_b[sidx] + s_li[sidx]) : 0.f; rs += pvv[i]; }
                    u32x2 pk2; pk2.x = pg8::cvt_pk_bf16(pvv[0], pvv[1]); pk2.y = pg8::cvt_pk_bf16(pvv[2], pvv[3]);
                    *(LASP u32x2*)(lds + OFF_P + t * RSP + (16 * sb + 4 * g) * 2) = pk2;
                    rs += shx(rs, 16, lane); rs += shx(rs, 32, lane);
                    if (g == 0) s_denp[sb * 64 + t] = rs; }
                if (wave == 0 && c + 1 < NC) MLSTM_GPREP(par ^ 1);
            } else {
                LASP const float* nsum = n_cur;
                const int t = (wave - 6) * 32 + (lane >> 1), kh = lane & 1; float acc = 0.f;
#pragma unroll
                for (int i = 0; i < 16; ++i) { float q8[8]; unpack8(*(const LASP u32x4*)(lds + OFF_Q + t * RSQ + (kh * 128 + i * 8) * 2), q8);
                    const f32x4 n0 = *(const LASP f32x4*)(nsum + kh * 128 + i * 8), n1 = *(const LASP f32x4*)(nsum + kh * 128 + i * 8 + 4);
                    acc += (q8[0] * n0[0] + q8[1] * n0[1]) + (q8[2] * n0[2] + q8[3] * n0[3]) + (q8[4] * n1[0] + q8[5] * n1[1]) + (q8[6] * n1[2] + q8[7] * n1[3]); }
                acc += shx(acc, 1, lane);
                if (kh == 0) s_qn[t] = acc;
            }
            __syncthreads();
            f32x4 acc[4];
#pragma unroll
            for (int tb = 0; tb < 4; ++tb) acc[tb] = (f32x4){0.f, 0.f, 0.f, 0.f};
            const float gam = s_misc[par];
            {   s16x4 Bc[4], Bn[4], Ac[4], An[4], V2t[4];
#pragma unroll
                for (int sb = 0; sb < 4; ++sb) V2t[sb] = tr_read4(lds + OFF_V2 + (16 * sb + 4 * g + (l15 >> 2)) * RSV + (16 * wave + 4 * (l15 & 3)) * 2);
#define MLSTM_LDB(dst, j) do { _Pragma("unroll") for (int tb = 0; tb < 4; ++tb) \
                    dst[tb] = *(const LASP s16x4*)(lds + OFF_Q + (16 * tb + l15) * RSQ + (16 * (j) + 4 * g) * 2); } while (0)
#define MLSTM_LDA(dst, j) do { _Pragma("unroll") for (int sb = 0; sb < 4; ++sb) \
                    dst[sb] = tr_read4(lds + OFF_K + (16 * sb + 4 * g + (l15 >> 2)) * RSK + (16 * (j) + 4 * (l15 & 3)) * 2); } while (0)
                MLSTM_LDB(Bc, 0); MLSTM_LDA(Ac, 0);
#pragma unroll
                for (int j = 0; j < 16; ++j) {
                    if (j < 15) { MLSTM_LDB(Bn, j + 1); MLSTM_LDA(An, j + 1); }
                    __builtin_amdgcn_sched_barrier(0);
                    { const s16x4 A = cvt4(S[j]);
#pragma unroll
                      for (int tb = 0; tb < 4; ++tb) acc[tb] = MFMA16(A, Bc[tb], acc[tb]);
                      S[j] = S[j] * gam;
#pragma unroll
                      for (int sb = 0; sb < 4; ++sb) S[j] = MFMA16(Ac[sb], V2t[sb], S[j]);
                      if ((j >> 1) == wave) {
                          f32x4 nn = Nn[j & 1] * gam;
#pragma unroll
                          for (int sb = 0; sb < 4; ++sb) nn = MFMA16(Ac[sb], *(const LASP s16x4*)(s_wb + par * 64 + 16 * sb + 4 * g), nn);
                          Nn[j & 1] = nn;
                          if (l15 == 0) *(LASP f32x4*)(n_nxt + 16 * j + 4 * g) = nn; } }
                    __builtin_amdgcn_sched_barrier(0);
#pragma unroll
                    for (int i = 0; i < 4; ++i) { Bc[i] = Bn[i]; Ac[i] = An[i]; }
                }
#undef MLSTM_LDB
#undef MLSTM_LDA
            }
            {   s16x4 Vt[4], Pb[10]; float ebv[4];
#pragma unroll
                for (int sb = 0; sb < 4; ++sb) Vt[sb] = tr_read4(lds + OFF_V + (16 * sb + 4 * g + (l15 >> 2)) * RSV + (16 * wave + 4 * (l15 & 3)) * 2);
#pragma unroll
                for (int tb = 0; tb < 4; ++tb) { ebv[tb] = s_eb[16 * tb + l15];
#pragma unroll
                    for (int sb = 0; sb <= tb; ++sb) Pb[(tb * (tb + 1)) / 2 + sb] = *(const LASP s16x4*)(lds + OFF_P + (16 * tb + l15) * RSP + (16 * sb + 4 * g) * 2); }
                __builtin_amdgcn_sched_barrier(0);
#pragma unroll
                for (int tb = 0; tb < 4; ++tb) { acc[tb] = acc[tb] * ebv[tb];
#pragma unroll
                    for (int sb = 0; sb <= tb; ++sb) acc[tb] = MFMA16(Vt[sb], Pb[(tb * (tb + 1)) / 2 + sb], acc[tb]); }
            }
#pragma unroll
            for (int tb = 0; tb < 4; ++tb) { const int t = 16 * tb + l15; float den = s_eb[t] * s_qn[t];
#pragma unroll
                for (int sb = 0; sb <= tb; ++sb) den += s_denp[sb * 64 + t];
                const float sc = 1.f / fmaxf(fabsf(den), 1.f); const f32x4 o = acc[tb] * sc;
                u32x2 pk2; pk2.x = pg8::cvt_pk_bf16(o[0], o[1]); pk2.y = pg8::cvt_pk_bf16(o[2], o[3]);
                *(u32x2*)((char*)(so + ((size_t)dir * T + chunk_row0(b, dir, c)) * D + h * 512 + vq * 128 + 16 * wave) + (size_t)(unsigned)((rix(dir, t) * D + 4 * g) * 2)) = pk2; }
            if (wave == 0 && c + 2 < NC) MLSTM_GLOAD(c + 2);
            __syncthreads();
        }
#undef MLSTM_LOAD
#undef MLSTM_GLOAD
#undef MLSTM_GPREP
    }
}

__device__ __forceinline__ void phase_ssd_chunk(int wv, const bf16* u, const float* gates, const float* a_log, const float* dt_bias, bf16* so, LASP unsigned char* lds) {
    constexpr int L = 64, RS = 272, RSK = 288, RSP = 144;
    constexpr int OFF_Q = 0, OFF_K = L * RS, OFF_V1 = OFF_K + L * RSK, OFF_V2 = OFF_V1 + L * RSK, OFF_P = OFF_V2 + L * RSK, OFF_F = OFF_P + 2 * L * RSP;
    const int tid = opaque_tid(wv), lane = tid & 63, wave = wv, g = lane >> 4, l15 = lane & 15, hh = wave >> 2;
    LASP float* fb = (LASP float*)(lds + OFF_F);
    LASP float* s_gvv = fb;
    LASP float* s_gm = fb + 1024;
    for (int item = blockIdx.x; item < BATCH * 8 * 2; item += gridDim.x) {
        const int b = item >> 4, hp = (item >> 1) & 7, dir = item & 1, grp = hp >> 2, hA = 2 * hp;
        const float Aneg = -__expf(a_log[dir * 16 + hA + (wave & 1)]), dtb = dt_bias[dir * 16 + hA + (wave & 1)];
        f32x4 S[8];
#pragma unroll
        for (int j = 0; j < 8; ++j) S[j] = (f32x4){0.f, 0.f, 0.f, 0.f};
        u32x4 pq[2], pk[2], pv[2]; float gd = 0.f;
        const int dso = (dir ? -32 : 32) * EV_MAIN * 2;
#define SSD_LOAD(c) do { const char* ub_ = (const char*)u + (size_t)chunk_row0(b, dir, (c)) * (EV_MAIN * 2); const int t_ = opaque_tid(wv); \
            const unsigned vo = (unsigned)((rix(dir, t_ >> 4) * EV_MAIN + EU_XBC + (t_ & 15) * 8) * 2); \
            _Pragma("unroll") for (int i = 0; i < 2; ++i) { const char* ur_ = ub_ + (size_t)(unsigned)(vo + i * dso); \
                pq[i] = *(const u32x4*)(ur_ + (1280 + grp * 128) * 2); pk[i] = *(const u32x4*)(ur_ + (1024 + grp * 128) * 2); pv[i] = *(const u32x4*)(ur_ + hA * 64 * 2); } \
            } while (0)
#define SSD_GLOAD(c) do { gd = gates[((size_t)chunk_row0(b, dir, (c)) + rix(dir, lane)) * 32 + dir * 16 + hA + (wave & 1)]; } while (0)
#define SSD_GPREP(par) do { const float dtv_ = softplus_(gd + dtb); float x_ = Aneg * dtv_; \
            _Pragma("unroll") for (int o = 1; o < 64; o <<= 1) { const float y_ = shup(x_, o, lane); if (lane >= o) x_ += y_; } \
            const float btot_ = rdlane(x_, 63); LASP float* gp_ = s_gvv + (par) * 512 + (wave & 1) * 64; \
            gp_[lane] = dtv_; gp_[128 + lane] = x_; gp_[256 + lane] = __expf(x_); gp_[384 + lane] = __expf(btot_ - x_); \
            if (lane == 0) s_gm[(par) * 2 + (wave & 1)] = __expf(btot_); } while (0)
        SSD_LOAD(0);
        if (wave >= 6) { SSD_GLOAD(0); SSD_GPREP(0); SSD_GLOAD(1); }
        for (int c = 0; c < (CTX + SEQ) / L; ++c) {
            const int par = c & 1;
            LASP float* s_dt = s_gvv + par * 512; LASP float* s_b = s_dt + 128; LASP float* s_eb = s_dt + 256; LASP float* s_w = s_dt + 384; LASP float* s_gam = s_gm + par * 2;
#pragma unroll
            for (int i = 0; i < 2; ++i) { const int idx = tid + i * 512, r = idx >> 4, pc = idx & 15; *(LASP u32x4*)(lds + OFF_Q + r * RS + pc * 16) = pq[i]; *(LASP u32x4*)(lds + OFF_K + r * RSK + pc * 16) = pk[i]; }
            __syncthreads();
#pragma unroll
            for (int i = 0; i < 2; ++i) { const int idx = tid + i * 512, r = idx >> 4, pc = idx & 15, hc = pc >> 3; const float dtv = s_dt[hc * 64 + r], w = s_w[hc * 64 + r];
                float x8[8]; unpack8(pv[i], x8);
#pragma unroll
                for (int j = 0; j < 8; ++j) x8[j] *= dtv;
                *(LASP u32x4*)(lds + OFF_V1 + r * RSK + pc * 16) = pack8(x8);
#pragma unroll
                for (int j = 0; j < 8; ++j) x8[j] *= w;
                *(LASP u32x4*)(lds + OFF_V2 + r * RSK + pc * 16) = pack8(x8); }
            if (c + 1 < (CTX + SEQ) / L) SSD_LOAD(c + 1);
            if (wave < 6) {
                const int tb = wave == 0 ? 0 : wave == 1 ? 1 : wave < 4 ? 2 : 3, sb0 = (wave == 3 || wave == 5) ? 2 : 0, ntl = (wave == 0 || wave == 3) ? 1 : 2;
                f32x4 ag0 = (f32x4){0.f, 0.f, 0.f, 0.f}, ag1 = (f32x4){0.f, 0.f, 0.f, 0.f};
                { s16x8 Gb[4], Ga0[4], Ga1[4];
#pragma unroll
                  for (int ks = 0; ks < 4; ++ks) { Gb[ks] = *(const LASP s16x8*)(lds + OFF_Q + (16 * tb + l15) * RS + ks * 64 + g * 16);
                      Ga0[ks] = *(const LASP s16x8*)(lds + OFF_K + (16 * sb0 + l15) * RSK + ks * 64 + g * 16);
                      Ga1[ks] = *(const LASP s16x8*)(lds + OFF_K + (16 * (sb0 + ntl - 1) + l15) * RSK + ks * 64 + g * 16); }
                  __builtin_amdgcn_sched_barrier(0);
#pragma unroll
                  for (int ks = 0; ks < 4; ++ks) { ag0 = MFMA32(Ga0[ks], Gb[ks], ag0); ag1 = MFMA32(Ga1[ks], Gb[ks], ag1); } }
                const int t = 16 * tb + l15;
#pragma unroll
                for (int q = 0; q < 2; ++q) { if (q >= ntl) break; const int sb = sb0 + q; const f32x4 ag = q == 0 ? ag0 : ag1;
#pragma unroll
                    for (int hd = 0; hd < 2; ++hd) { const float bt = s_b[hd * 64 + t]; float pvv[4];
#pragma unroll
                        for (int i = 0; i < 4; ++i) { const int sidx = 16 * sb + 4 * g + i; pvv[i] = sidx <= t ? ag[i] * __expf(bt - s_b[hd * 64 + sidx]) : 0.f; }
                        u32x2 pk2; pk2.x = pg8::cvt_pk_bf16(pvv[0], pvv[1]); pk2.y = pg8::cvt_pk_bf16(pvv[2], pvv[3]);
                        *(LASP u32x2*)(lds + OFF_P + hd * L * RSP + t * RSP + (16 * sb + 4 * g) * 2) = pk2; } }
            } else if (c + 1 < (CTX + SEQ) / L) SSD_GPREP(par ^ 1);
            __syncthreads();
            f32x4 acc[4];
#pragma unroll
            for (int tb = 0; tb < 4; ++tb) acc[tb] = (f32x4){0.f, 0.f, 0.f, 0.f};
            {   s16x4 Bc[16], Bn[16];
#define SSD_LDB(dst, jb) do { _Pragma("unroll") for (int jj = 0; jj < 4; ++jj) _Pragma("unroll") for (int tb = 0; tb < 4; ++tb) \
                    dst[jj * 4 + tb] = *(const LASP s16x4*)(lds + OFF_Q + (16 * tb + l15) * RS + (16 * ((jb) * 4 + jj) + 4 * g) * 2); } while (0)
                SSD_LDB(Bc, 0);
#pragma unroll
                for (int jb = 0; jb < 2; ++jb) {
                    if (jb < 1) SSD_LDB(Bn, jb + 1);
                    __builtin_amdgcn_sched_barrier(0);
#pragma unroll
                    for (int jj = 0; jj < 4; ++jj) { const s16x4 A = cvt4(S[jb * 4 + jj]);
#pragma unroll
                        for (int tb = 0; tb < 4; ++tb) acc[tb] = MFMA16(A, Bc[jj * 4 + tb], acc[tb]); }
                    __builtin_amdgcn_sched_barrier(0);
#pragma unroll
                    for (int i = 0; i < 16; ++i) Bc[i] = Bn[i];
                }
#undef SSD_LDB
            }
            s16x4 Vt[4];
            {   s16x4 Pb[10]; float ebv[4];
#pragma unroll
                for (int sb = 0; sb < 4; ++sb) Vt[sb] = tr_read4(lds + OFF_V1 + (16 * sb + 4 * g + (l15 >> 2)) * RSK + (16 * wave + 4 * (l15 & 3)) * 2);
#pragma unroll
                for (int tb = 0; tb < 4; ++tb) { ebv[tb] = s_eb[hh * 64 + 16 * tb + l15];
#pragma unroll
                    for (int sb = 0; sb <= tb; ++sb) Pb[(tb * (tb + 1)) / 2 + sb] = *(const LASP s16x4*)(lds + OFF_P + hh * L * RSP + (16 * tb + l15) * RSP + (16 * sb + 4 * g) * 2); }
                __builtin_amdgcn_sched_barrier(0);
#pragma unroll
                for (int tb = 0; tb < 4; ++tb) { acc[tb] = acc[tb] * ebv[tb];
#pragma unroll
                    for (int sb = 0; sb <= tb; ++sb) acc[tb] = MFMA16(Vt[sb], Pb[(tb * (tb + 1)) / 2 + sb], acc[tb]); }
            }
#pragma unroll
            for (int tb = 0; tb < 4; ++tb) { const int t = 16 * tb + l15; const f32x4 o = acc[tb];
                u32x2 pk2; pk2.x = pg8::cvt_pk_bf16(o[0], o[1]); pk2.y = pg8::cvt_pk_bf16(o[2], o[3]);
                *(u32x2*)((char*)(so + ((size_t)dir * T + chunk_row0(b, dir, c)) * D + hA * 64 + 16 * wave) + (size_t)(unsigned)((rix(dir, t) * D + 4 * g) * 2)) = pk2; }
#pragma unroll
            for (int sb = 0; sb < 4; ++sb) Vt[sb] = tr_read4(lds + OFF_V2 + (16 * sb + 4 * g + (l15 >> 2)) * RSK + (16 * wave + 4 * (l15 & 3)) * 2);
            if (wave >= 6 && c + 2 < (CTX + SEQ) / L) SSD_GLOAD(c + 2);
            const float gam = s_gam[hh];
            {   s16x4 Ac[16], An[16];
#define SSD_LDA(dst, jb) do { _Pragma("unroll") for (int jj = 0; jj < 4; ++jj) _Pragma("unroll") for (int sb = 0; sb < 4; ++sb) \
                    dst[jj * 4 + sb] = tr_read4(lds + OFF_K + (16 * sb + 4 * g + (l15 >> 2)) * RSK + (16 * ((jb) * 4 + jj) + 4 * (l15 & 3)) * 2); } while (0)
                SSD_LDA(Ac, 0);
#pragma unroll
                for (int jb = 0; jb < 2; ++jb) {
                    if (jb < 1) SSD_LDA(An, jb + 1);
                    __builtin_amdgcn_sched_barrier(0);
#pragma unroll
                    for (int jj = 0; jj < 4; ++jj) { S[jb * 4 + jj] = S[jb * 4 + jj] * gam;
#pragma unroll
                        for (int sb = 0; sb < 4; ++sb) S[jb * 4 + jj] = MFMA16(Ac[jj * 4 + sb], Vt[sb], S[jb * 4 + jj]); }
                    __builtin_amdgcn_sched_barrier(0);
#pragma unroll
                    for (int i = 0; i < 16; ++i) Ac[i] = An[i];
                }
#undef SSD_LDA
            }
            __syncthreads();
        }
#undef SSD_LOAD
#undef SSD_GLOAD
#undef SSD_GPREP
    }
}

__device__ __forceinline__ void phase_hgrn_chunk(int wv, const bf16* u, const float* hlb, int e, bf16* so, LASP unsigned char* lds) {
    constexpr int L = 64, RS = 272, RSK = 288, RSP = 40;
    constexpr int OFF_Z = 0  , OFF_Q = L * RS  , OFF_KP = 2 * L * RS, OFF_V = OFF_KP + L * RSK, OFF_P = OFF_V + L * RSK, OFF_G = OFF_P + 4 * 16 * RSP;
    const int tid = opaque_tid(wv), lane = tid & 63, wave = wv, g = lane >> 4, l15 = lane & 15;
    LASP float* s_g = (LASP float*)(lds + OFF_G);
    for (int item = blockIdx.x; item < BATCH * 8 * 2; item += gridDim.x) {
        const int b = item >> 4, h = (item >> 1) & 7, dir = item & 1;
        const int ep = tid & 63, esub = (tid >> 6) & 3;
        f32x2 lb2 = (f32x2){0.f, 0.f};
        if (e != 0) { lb2.x = sigmoid_(hlb[1024 + h * 128 + 2 * ep] - hlb[h * 128 + 2 * ep]); lb2.y = sigmoid_(hlb[1024 + h * 128 + 2 * ep + 1] - hlb[h * 128 + 2 * ep + 1]); }
        const f32x2 oml2 = (f32x2){1.f, 1.f} - lb2;
        f32x4 S[8];
#pragma unroll
        for (int j = 0; j < 8; ++j) S[j] = (f32x4){0.f, 0.f, 0.f, 0.f};
        u32x4 pz[2], pq[2], pv[2];
        const int dso = (dir ? -32 : 32) * EV_MAIN * 2;
#define HGRN_LOAD(c) do { const char* ub_ = (const char*)u + (size_t)chunk_row0(b, dir, (c)) * (EV_MAIN * 2); const int t_ = opaque_tid(wv); \
            const unsigned vo = (unsigned)((rix(dir, t_ >> 4) * EV_MAIN + h * 128 + (t_ & 15) * 8) * 2); \
            _Pragma("unroll") for (int i = 0; i < 2; ++i) { const char* ur_ = ub_ + (size_t)(unsigned)(vo + i * dso); \
                pz[i] = *(const u32x4*)(ur_ + (EU_F + dir * 1024) * 2); pq[i] = *(const u32x4*)(ur_ + EU_Q * 2); pv[i] = *(const u32x4*)(ur_ + EU_I * 2); } } while (0)
        HGRN_LOAD(0);
        for (int c = 0; c < (CTX + SEQ) / L; ++c) {
#pragma unroll
            for (int i = 0; i < 2; ++i) { const int idx = tid + i * 512, r = idx >> 4, pc = idx & 15;
                *(LASP u32x4*)(lds + OFF_Z + r * RS + pc * 16) = pz[i]; *(LASP u32x4*)(lds + OFF_Q + r * RS + pc * 16) = pq[i]; *(LASP u32x4*)(lds + OFF_V + r * RSK + pc * 16) = pv[i]; }
            __syncthreads();
            if (c + 1 < (CTX + SEQ) / L) HGRN_LOAD(c + 1);
            if (wave < 4) { f32x2 pf[16], kin[16]; f32x2 run = (f32x2){1.f, 1.f};
#pragma unroll
              for (int t = 0; t < 16; ++t) { const unsigned zw = *(const LASP unsigned*)(lds + OFF_Z + (esub * 16 + t) * RS + ep * 4);
                  const f32x2 zf = (f32x2){fminf(bf_lo(zw), 30.f), fminf(bf_hi(zw), 30.f)};
                  const f32x2 ez = (f32x2){__expf(zf.x), __expf(zf.y)}, sneg = (f32x2){__builtin_amdgcn_rcpf(1.f + ez.x), __builtin_amdgcn_rcpf(1.f + ez.y)}, spos = ez * sneg;
                  const f32x2 f = lb2 + oml2 * spos; kin[t] = oml2 * sneg; run = run * f; run.x = fmaxf(run.x, 1e-30f); run.y = fmaxf(run.y, 1e-30f); pf[t] = run; }
#pragma unroll
              for (int t = 0; t < 16; ++t) { LASP unsigned* zp = (LASP unsigned*)(lds + OFF_Z + (esub * 16 + t) * RS + ep * 4); LASP unsigned* qp = (LASP unsigned*)(lds + OFF_Q + (esub * 16 + t) * RS + ep * 4);
                  LASP unsigned* kp = (LASP unsigned*)(lds + OFF_KP + (esub * 16 + t) * RSK + ep * 4);
                  const unsigned qw = *qp; const f32x2 qr = (f32x2){bf_lo(qw), bf_hi(qw)};
                  const f32x2 sg = (f32x2){__builtin_amdgcn_rcpf(1.f + __expf(-qr.x)), __builtin_amdgcn_rcpf(1.f + __expf(-qr.y))}, q = qr * sg * pf[t];
                  const f32x2 ipf = (f32x2){__builtin_amdgcn_rcpf(pf[t].x), __builtin_amdgcn_rcpf(pf[t].y)}, ks = kin[t] * ipf, kpv = ks * run;
                  *qp = pg8::cvt_pk_bf16(q.x, q.y); *zp = pg8::cvt_pk_bf16(ks.x, ks.y); *kp = pg8::cvt_pk_bf16(kpv.x, kpv.y); }
              *(LASP f32x2*)(s_g + esub * 128 + 2 * ep) = run; }
            __syncthreads();
            if (wave < 4) {
                f32x4 ag = (f32x4){0.f, 0.f, 0.f, 0.f};
#pragma unroll
                for (int ks = 0; ks < 4; ++ks) {
                    const s16x8 A = *(const LASP s16x8*)(lds + OFF_Z + (16 * wave + l15) * RS + ks * 64 + g * 16);
                    const s16x8 B = *(const LASP s16x8*)(lds + OFF_Q + (16 * wave + l15) * RS + ks * 64 + g * 16);
                    ag = MFMA32(A, B, ag);
                }
                float pvv[4];
#pragma unroll
                for (int i = 0; i < 4; ++i) pvv[i] = (4 * g + i) <= l15 ? ag[i] : 0.f;
                u32x2 pk2; pk2.x = pg8::cvt_pk_bf16(pvv[0], pvv[1]); pk2.y = pg8::cvt_pk_bf16(pvv[2], pvv[3]);
                *(LASP u32x2*)(lds + OFF_P + wave * 16 * RSP + l15 * RSP + 8 * g) = pk2;
            }
            __syncthreads();
#pragma unroll
            for (int sub = 0; sub < 4; ++sub) {
                f32x4 acc = (f32x4){0.f, 0.f, 0.f, 0.f};
                s16x4 Bq[8], Ak[8]; f32x4 gsv[8];
#pragma unroll
                for (int j = 0; j < 8; ++j) Bq[j] = *(const LASP s16x4*)(lds + OFF_Q + (16 * sub + l15) * RS + (16 * j + 4 * g) * 2);
                const s16x4 Vt = tr_read4(lds + OFF_V + (16 * sub + 4 * g + (l15 >> 2)) * RSK + (16 * wave + 4 * (l15 & 3)) * 2);
                const s16x4 Pt = *(const LASP s16x4*)(lds + OFF_P + sub * 16 * RSP + l15 * RSP + 8 * g);
#pragma unroll
                for (int j = 0; j < 8; ++j) { Ak[j] = tr_read4(lds + OFF_KP + (16 * sub + 4 * g + (l15 >> 2)) * RSK + (16 * j + 4 * (l15 & 3)) * 2); gsv[j] = *(const LASP f32x4*)(s_g + sub * 128 + 16 * j + 4 * g); }
                __builtin_amdgcn_sched_barrier(0);
                f32x4 acc2 = (f32x4){0.f, 0.f, 0.f, 0.f};
#pragma unroll
                for (int j = 0; j < 8; j += 2) { acc = MFMA16(cvt4(S[j]), Bq[j], acc); acc2 = MFMA16(cvt4(S[j + 1]), Bq[j + 1], acc2); }
                acc2 = MFMA16(Vt, Pt, acc2);
                acc = acc + acc2;
                { u32x2 pk2; pk2.x = pg8::cvt_pk_bf16(acc[0], acc[1]); pk2.y = pg8::cvt_pk_bf16(acc[2], acc[3]);
                  *(u32x2*)((char*)(so + ((size_t)dir * T + chunk_row0(b, dir, c)) * D + 1024 + h * 128 + 16 * wave) + (size_t)(unsigned)((rix(dir, 16 * sub + l15) * D + 4 * g) * 2)) = pk2; }
#pragma unroll
                for (int j = 0; j < 8; ++j) S[j] = MFMA16(Ak[j], Vt, S[j] * gsv[j]);
            }
            __syncthreads();
        }
#undef HGRN_LOAD
    }
}

__device__ __forceinline__ void phase_out_even(int wv, const bf16* u, const bf16* so, const float* dskip, const float* ssd_nw, const float* hgrn_nw, bf16* y, int row_lo) {
    const int tid = opaque_tid(wv), lane = tid & 63, wave = wv;
    const int gw = blockIdx.x * 8 + wave, nwv = gridDim.x * 8;
    for (int row = row_lo + gw; row < T; row += nwv) {
        const bf16* ur = u + (size_t)row * EV_MAIN; const bf16* sr = so + (size_t)row * D; const bf16* sr2 = so + ((size_t)T + row) * D;
        u32x4 rxs[2], rz[2], rg[2], rsa[4], rsb[4]; f32x4 nwa[4][2];
#pragma unroll
        for (int j = 0; j < 2; ++j) { const int c = j * 512 + lane * 8; rxs[j] = *(const u32x4*)(ur + EU_XBC + c); rz[j] = *(const u32x4*)(ur + EU_Z + c); rg[j] = *(const u32x4*)(ur + EU_G + c);
            nwa[j][0] = *(const f32x4*)(ssd_nw + c); nwa[j][1] = *(const f32x4*)(ssd_nw + c + 4); nwa[2 + j][0] = *(const f32x4*)(hgrn_nw + c); nwa[2 + j][1] = *(const f32x4*)(hgrn_nw + c + 4); }
#pragma unroll
        for (int j = 0; j < 4; ++j) { const int c = j * 512 + lane * 8; rsa[j] = *(const u32x4*)(sr + c); rsb[j] = *(const u32x4*)(sr2 + c); }
#pragma unroll
        for (int j = 0; j < 2; ++j) {
            const int c = j * 512 + lane * 8;
            float xs[8], z[8], val[8], sa[8], sb[8]; unpack8(rxs[j], xs); unpack8(rz[j], z); unpack8(rsa[j], sa); unpack8(rsb[j], sb);
            const float dsk = dskip[c >> 6]; float ss = 0.f;
#pragma unroll
            for (int i = 0; i < 8; ++i) { const float yy = (sa[i] + sb[i]) + xs[i] * dsk; val[i] = yy * silu_(z[i]); ss += val[i] * val[i]; }
            ss = wave_sum(ss, lane);
            const float rs = rsqrtf(ss * (1.f / 512.f) + EPS);
#pragma unroll
            for (int i = 0; i < 8; ++i) val[i] = val[i] * rs * (i < 4 ? nwa[j][0][i] : nwa[j][1][i - 4]);
            *(u32x4*)(y + pg8::tiled_off((size_t)row, c, D)) = pack8(val);
        }
#pragma unroll
        for (int j = 0; j < 2; ++j) {
            const int c = j * 512 + lane * 8;
            float gg[8], val[8], sa[8], sb[8]; unpack8(rg[j], gg); unpack8(rsa[2 + j], sa); unpack8(rsb[2 + j], sb);
            float ss = 0.f;
#pragma unroll
            for (int i = 0; i < 8; ++i) { val[i] = sa[i] + sb[i]; ss += val[i] * val[i]; }
            ss += shx(ss, 1, lane); ss += shx(ss, 2, lane); ss += shx(ss, 4, lane); ss += shx(ss, 8, lane);
            const float rs = rsqrtf(ss * (1.f / 128.f) + EPS);
#pragma unroll
            for (int i = 0; i < 8; ++i) val[i] = val[i] * rs * (i < 4 ? nwa[2 + j][0][i] : nwa[2 + j][1][i - 4]) * silu_(gg[i]);
            *(u32x4*)(y + pg8::tiled_off((size_t)row, 1024 + c, D)) = pack8(val);
        }
    }
}
__device__ __forceinline__ void phase_out_odd(int wv, const bf16* u, const bf16* so, const float* nw, bf16* y, int row_lo) {
    const int tid = opaque_tid(wv), lane = tid & 63, wave = wv;
    const int gw = blockIdx.x * 8 + wave, nwv = gridDim.x * 8;
    for (int row = row_lo + gw; row < T; row += nwv) {
        const bf16* ur = u + (size_t)row * OD_MAIN; const bf16* sr = so + (size_t)row * D; const bf16* sr2 = so + ((size_t)T + row) * D;
        u32x4 rog[4], rsa[4], rsb[4]; f32x4 nwa[4][2];
#pragma unroll
        for (int j = 0; j < 4; ++j) { const int c = j * 512 + lane * 8; rog[j] = *(const u32x4*)(ur + OU_O + c); rsa[j] = *(const u32x4*)(sr + c); rsb[j] = *(const u32x4*)(sr2 + c);
            nwa[j][0] = *(const f32x4*)(nw + c); nwa[j][1] = *(const f32x4*)(nw + c + 4); }
#pragma unroll
        for (int j = 0; j < 4; ++j) {
            const int c = j * 512 + lane * 8;
            float og[8], val[8], sa[8], sb[8]; unpack8(rog[j], og); unpack8(rsa[j], sa); unpack8(rsb[j], sb);
            float ss = 0.f;
#pragma unroll
            for (int i = 0; i < 8; ++i) { val[i] = sa[i] + sb[i]; ss += val[i] * val[i]; }
            ss = wave_sum(ss, lane);
            const float rs = rsqrtf(ss * (1.f / 512.f) + EPS);
#pragma unroll
            for (int i = 0; i < 8; ++i) val[i] = val[i] * rs * (i < 4 ? nwa[j][0][i] : nwa[j][1][i - 4]) * sigmoid_(og[i]);
            *(u32x4*)(y + pg8::tiled_off((size_t)row, c, D)) = pack8(val);
        }
    }
}

__device__ __forceinline__ float dpp_ror1(float v) { return __int_as_float(__builtin_amdgcn_update_dpp(0, __float_as_int(v), 0x121, 0xf, 0xf, false)); }
__device__ __forceinline__ float dpp_rol1(float v) { return __int_as_float(__builtin_amdgcn_update_dpp(0, __float_as_int(v), 0x12f, 0xf, 0xf, false)); }
struct EpiU {
    static constexpr bool PERM = true, AFTER_DRAIN = false;
    bf16* U; int ldu; int n_main; float* gates;
    const float* cw; const float* cb; int cv_lo, cv_hi, nch, ks_pn; LASP unsigned char* lds;
    __device__ __forceinline__ void operator()(const f32x4 (&acc)[2][2][4][2], const pg8::Unit& u, int wr, int wc, int fr, int fq) const {
        int row0 = u.pm * 256 + wr * 64 + fr; asm volatile("" : "+v"(row0));
        if (u.pn < n_main) {
            const int col0 = u.pn * 256 + wc * 32 + 8 * fq;
            if (u.pn < cv_lo || u.pn >= cv_hi) {
#pragma unroll
                for (int ai = 0; ai < 2; ++ai)
#pragma unroll
                    for (int m = 0; m < 4; ++m) { bf16* rowp = U + (size_t)(row0 + ai * 128 + m * 16) * ldu + col0;
#pragma unroll
                        for (int bj = 0; bj < 2; ++bj) { const f32x4 v0 = acc[ai][bj][m][0], v1 = acc[ai][bj][m][1];
                            u32x4 w; w.x = pg8::cvt_pk_bf16(v0[0], v0[1]); w.y = pg8::cvt_pk_bf16(v0[2], v0[3]); w.z = pg8::cvt_pk_bf16(v1[0], v1[1]); w.w = pg8::cvt_pk_bf16(v1[2], v1[3]);
                            *(u32x4*)(rowp + bj * 128) = w; } }
            } else {
                const bool ctx = u.pm < 16; const float post = u.pn >= ks_pn ? 0.0625f : 1.f;
                const int lc0 = wc * 32 + 8 * fq, ch0 = (u.pn - cv_lo) * 256 + lc0;
                LASP float* EX = (LASP float*)(lds + 131072);
                if (ctx) {
#pragma unroll
                    for (int ai = 0; ai < 2; ++ai) { const int k = ai * 2 + wr;
#pragma unroll
                        for (int bj = 0; bj < 2; ++bj)
#pragma unroll
                            for (int n = 0; n < 2; ++n) {
                                if (fr == 0) *(LASP f32x4*)(EX + (k * 2 + 0) * 256 + bj * 128 + lc0 + 4 * n) = acc[ai][bj][0][n];
                                if (fr == 15) *(LASP f32x4*)(EX + (k * 2 + 1) * 256 + bj * 128 + lc0 + 4 * n) = acc[ai][bj][3][n]; } }
                    asm volatile("s_waitcnt lgkmcnt(0)" ::: "memory"); __builtin_amdgcn_s_barrier(); asm volatile("" ::: "memory");
                }
#pragma unroll
                for (int bj = 0; bj < 2; ++bj) {
                    f32x4 w0[2], w1[2], w2[2], bb[2];
#pragma unroll
                    for (int n = 0; n < 2; ++n) { const int ch = ch0 + bj * 128 + 4 * n;
                        w0[n] = *(const f32x4*)(cw + ch); w1[n] = *(const f32x4*)(cw + nch + ch); w2[n] = *(const f32x4*)(cw + 2 * nch + ch); bb[n] = *(const f32x4*)(cb + ch); }
#pragma unroll
                    for (int ai = 0; ai < 2; ++ai) { const int k = ai * 2 + wr;
                        f32x4 bprev[2], bnext[2];
#pragma unroll
                        for (int n = 0; n < 2; ++n) { bprev[n] = (f32x4){0.f, 0.f, 0.f, 0.f}; bnext[n] = (f32x4){0.f, 0.f, 0.f, 0.f};
                            if (ctx) { if (k > 0) bprev[n] = *(const LASP f32x4*)(EX + ((k - 1) * 2 + 1) * 256 + bj * 128 + lc0 + 4 * n);
                                       if (k < 3) bnext[n] = *(const LASP f32x4*)(EX + ((k + 1) * 2 + 0) * 256 + bj * 128 + lc0 + 4 * n); } }
#pragma unroll
                        for (int m = 0; m < 4; ++m) { float o[2][4];
#pragma unroll
                            for (int n = 0; n < 2; ++n)
#pragma unroll
                                for (int i = 0; i < 4; ++i) {
                                    const float rs_ = dpp_ror1(acc[ai][bj][m][n][i]), rp_ = m > 0 ? dpp_ror1(acc[ai][bj][m > 0 ? m - 1 : 0][n][i]) : bprev[n][i];
                                    const float ls_ = dpp_rol1(acc[ai][bj][m][n][i]), ln_ = m < 3 ? dpp_rol1(acc[ai][bj][m < 3 ? m + 1 : 3][n][i]) : bnext[n][i];
                                    const float pv = fr == 0 ? rp_ : rs_, nx = fr == 15 ? ln_ : ls_;
                                    const float a = bb[n][i] + w0[n][i] * pv + w1[n][i] * acc[ai][bj][m][n][i] + w2[n][i] * nx;
                                    o[n][i] = a * __builtin_amdgcn_rcpf(1.f + __expf(-a)) * post; }
                            u32x4 w; w.x = pg8::cvt_pk_bf16(o[0][0], o[0][1]); w.y = pg8::cvt_pk_bf16(o[0][2], o[0][3]); w.z = pg8::cvt_pk_bf16(o[1][0], o[1][1]); w.w = pg8::cvt_pk_bf16(o[1][2], o[1][3]);
                            *(u32x4*)(U + (size_t)(row0 + ai * 128 + m * 16) * ldu + col0 + bj * 128) = w; } } }
            }
        } else if (wc == 0) {
#pragma unroll
            for (int ai = 0; ai < 2; ++ai)
#pragma unroll
                for (int m = 0; m < 4; ++m) { float* gp = gates + (size_t)(row0 + ai * 128 + m * 16) * 32 + 8 * fq;
                    *(f32x4*)gp = acc[ai][0][m][0]; *(f32x4*)(gp + 4) = acc[ai][0][m][1]; }
        }
    }
};
struct EpiAct {
    static constexpr bool PERM = true, AFTER_DRAIN = false;
    bf16* O; int ldc;
    __device__ __forceinline__ void operator()(const f32x4 (&acc)[2][2][4][2], const pg8::Unit& u, int wr, int wc, int fr, int fq) const {
        int row0 = u.pm * 256 + wr * 64 + fr; asm volatile("" : "+v"(row0)); const int col0 = u.pn * 256 + wc * 32 + 8 * fq;
#pragma unroll
        for (int ai = 0; ai < 2; ++ai)
#pragma unroll
            for (int m = 0; m < 4; ++m) { bf16* rowp = O + pg8::tiled_off((size_t)(row0 + ai * 128 + m * 16), col0, ldc);
#pragma unroll
                for (int bj = 0; bj < 2; ++bj) { f32x4 v0 = acc[ai][bj][m][0], v1 = acc[ai][bj][m][1];
#pragma unroll
                    for (int i = 0; i < 4; ++i) { const float a = fmaxf(v0[i], 0.f), b = fmaxf(v1[i], 0.f); v0[i] = a * a; v1[i] = b * b; }
                    u32x4 w; w.x = pg8::cvt_pk_bf16(v0[0], v0[1]); w.y = pg8::cvt_pk_bf16(v0[2], v0[3]); w.z = pg8::cvt_pk_bf16(v1[0], v1[1]); w.w = pg8::cvt_pk_bf16(v1[2], v1[3]);
                    *(u32x4*)(rowp + bj * (2 * 256 * 64)) = w; } }
    }
};
struct EpiRes {
    static constexpr bool PERM = true, AFTER_DRAIN = false;
    const void* xc_in; bf16* xc_out; const void* xl_in; bf16* xl_out; int in_f32; const float* gate_base; int pm_off; float* pb;
    __device__ __forceinline__ void operator()(const f32x4 (&acc)[2][2][4][2], const pg8::Unit& u, int wr, int wc, int fr, int fq) const {
        const int pmg = u.pm + pm_off;
        const void* rin; bf16* rout; int gr; size_t rbase;
        if (pmg < 16) { rin = xc_in; rout = xc_out; rbase = (size_t)pmg * 256; gr = 16; }
        else { rin = xl_in; rout = xl_out; rbase = (size_t)(pmg - 16) * 256; gr = (pmg - 16) >> 3; }
        const float* gate = gate_base + (size_t)gr * MODW;
        int row0 = wr * 64 + fr; asm volatile("" : "+v"(row0)); const int col0 = u.pn * 256 + wc * 32 + 8 * fq;
        f32x4 gv[2][2];
#pragma unroll
        for (int bj = 0; bj < 2; ++bj)
#pragma unroll
            for (int n = 0; n < 2; ++n) gv[bj][n] = *(const f32x4*)(gate + col0 + bj * 128 + n * 4);
        if (u.part == 2) {
            float* po = pb + (size_t)pmg * 256 * D;
#pragma unroll
            for (int ai = 0; ai < 2; ++ai)
#pragma unroll
                for (int m = 0; m < 4; ++m) { const size_t off = (size_t)(row0 + ai * 128 + m * 16) * D + col0;
#pragma unroll
                    for (int bj = 0; bj < 2; ++bj)
#pragma unroll
                        for (int n = 0; n < 2; ++n) *(f32x4*)(po + off + bj * 128 + n * 4) = gv[bj][n] * acc[ai][bj][m][n]; }
            return;
        }
        if (in_f32) {
#pragma unroll
            for (int ai = 0; ai < 2; ++ai)
#pragma unroll
                for (int m = 0; m < 4; ++m) { const size_t off = (rbase + row0 + ai * 128 + m * 16) * D + col0; float r[2][8];
#pragma unroll
                    for (int bj = 0; bj < 2; ++bj) load_x8(rin, true, off + bj * 128, r[bj]);
#pragma unroll
                    for (int bj = 0; bj < 2; ++bj) {
#pragma unroll
                        for (int i = 0; i < 4; ++i) { r[bj][i] += gv[bj][0][i] * acc[ai][bj][m][0][i]; r[bj][4 + i] += gv[bj][1][i] * acc[ai][bj][m][1][i]; }
                        *(u32x4*)(rout + off + bj * 128) = pack8(r[bj]); } }
        } else {
            u32x4 xr[2][4][2];
#pragma unroll
            for (int ai = 0; ai < 2; ++ai)
#pragma unroll
                for (int m = 0; m < 4; ++m)
#pragma unroll
                    for (int bj = 0; bj < 2; ++bj) xr[ai][m][bj] = *(const u32x4*)((const bf16*)rin + (rbase + row0 + ai * 128 + m * 16) * D + col0 + bj * 128);
#pragma unroll
            for (int ai = 0; ai < 2; ++ai)
#pragma unroll
                for (int m = 0; m < 4; ++m) { const size_t off = (rbase + row0 + ai * 128 + m * 16) * D + col0;
#pragma unroll
                    for (int bj = 0; bj < 2; ++bj) { float r[8]; unpack8(xr[ai][m][bj], r);
#pragma unroll
                        for (int i = 0; i < 4; ++i) { r[i] += gv[bj][0][i] * acc[ai][bj][m][0][i]; r[4 + i] += gv[bj][1][i] * acc[ai][bj][m][1][i]; }
                        *(u32x4*)(rout + off + bj * 128) = pack8(r); } }
        }
    }
};

constexpr int NPH = 1 + 9 * DEPTH + 1;

__device__ __forceinline__ int opaque_gdim() { int g = (int)gridDim.x; asm volatile("" : "+s"(g)); return g; }
__global__ void __launch_bounds__(512, 2) fwd_kernel(Params p) {
    asm volatile("s_nop 0\ns_nop 0\ns_nop 0\ns_nop 0\ns_nop 0\ns_nop 0\ns_nop 0\ns_nop 0");
    extern __shared__ __attribute__((aligned(16))) unsigned char lds_raw[];
    LASP unsigned char* lds = (LASP unsigned char*)lds_raw;
    int wv = __builtin_amdgcn_readfirstlane((int)(threadIdx.x >> 6)); asm volatile("" : "+s"(wv));
    const int tid = opaque_tid(wv);
    unsigned char* ws = p.ws;
#if ONE_LAUNCH
    constexpr int lo = 0, hi = NPH;
#else
    const int lo = p.ph_lo, hi = p.ph_hi;
#endif
    const bool multi = (hi - lo) > 1;
    XcdBarrier bar; bar.bar = (unsigned*)(ws + WS_CTL) + CW_BAR; bar.x = 0; bar.st = nullptr; bar.wv = wv;
    if (multi) {
        if (tid < 4) ((LASP unsigned*)(lds + LDS_BARW))[tid] = 0u;
        __syncthreads();
        bar = xcd_barrier_post((unsigned*)(ws + WS_CTL) + CW_BAR, (volatile LASP unsigned*)(lds + LDS_BARW), wv);
    }
#define IN(k) (lo <= (k) && (k) < hi)
#define SEAM(k) do { if ((k) + 1 < hi) { bar.x = xb_xcc_id(); xcd_barrier(bar); } } while (0)

    float* mod = (float*)(ws + WS_MOD);
    float* gates = (float*)(ws + WS_GATES);
    bf16* xc = (bf16*)(ws + WS_XC);
    bf16* xl = (bf16*)(ws + WS_XL);
    bf16* hbuf = (bf16*)(ws + WS_H);
    bf16* ubuf = (bf16*)(ws + WS_U);
#define split_ok (opaque_gdim() == 256)
    float* pbuf = (float*)(ws + WS_SO);
    bf16* so = (bf16*)(ws + WS_SO);
    unsigned char* wl = ws + WS_WT;
    const bf16* w_in = (const bf16*)wl; const bf16* w_out = (const bf16*)(wl + WT_IN_E);
    const bf16* w1 = (const bf16*)(wl + WT_IN_E + WT_OUT); const bf16* w2 = (const bf16*)(wl + WT_IN_E + WT_OUT + WT_W1);
    LASP float* tile = (LASP float*)lds;
#define CONVERT_LAYER(l_) do { const int e_ = (l_) >> 1; \
        if (((l_) & 1) == 0) { convert_wt(wv, pin(p, I_EWIN) + (size_t)e_ * D * EVEN_IN, D, EVEN_IN, EVEN_IN, (bf16*)wl, EV_PAD, 1, tile); \
                               convert_wt(wv, pin(p, I_EWOUT) + (size_t)e_ * D * D, D, D, D, (bf16*)(wl + WT_IN_E), D, 0, tile); } \
        else { convert_wt(wv, pin(p, I_OWIN) + (size_t)e_ * D * ODD_IN, D, ODD_IN, ODD_IN, (bf16*)wl, OD_PAD, 0, tile); \
               convert_wt(wv, pin(p, I_OWOUT) + (size_t)e_ * D * D, D, D, D, (bf16*)(wl + WT_IN_E), D, 0, tile); } \
        convert_wt(wv, pin(p, I_W1) + (size_t)(l_) * D * DFF, D, DFF, DFF, (bf16*)(wl + WT_IN_E + WT_OUT), DFF, 0, tile); \
        convert_wt(wv, pin(p, I_W2) + (size_t)(l_) * DFF * D, DFF, D, D, (bf16*)(wl + WT_IN_E + WT_OUT + WT_W1), D, 0, tile); } while (0)

    if (IN(0)) {
        CONVERT_LAYER(0);
        __syncthreads();
        phase_mod(wv, p, lds);
        SEAM(0);
    }

    for (int l = 0; l < DEPTH; ++l) {
        const int pb = 1 + 9 * l, e = l >> 1;
        const bool odd = (l & 1) != 0, last = (l == DEPTH - 1), first = (l == 0);
        const float* modl = mod + (size_t)l * 17 * MODW;
        const void* xc_cur = first ? (const void*)pin(p, I_CTX) : (const void*)xc;
        const void* xl_cur = first ? (const void*)pin(p, I_X) : (const void*)xl;
        const int ldu = odd ? OD_MAIN : EV_MAIN;
        const int row_lo2 = last ? TC : 0;

        if (IN(pb + 0)) {
            phase_norm(wv, xc_cur, xl_cur, first, pin(p, I_NORMW) + (size_t)(l * 2 + 0) * D, modl, 1, 0, hbuf, 0, (!first && split_ok) ? pbuf : (const float*)nullptr, xc, lds);
            if (!first) CONVERT_LAYER(l);
            SEAM(pb + 0);
        }
        if (IN(pb + 1)) {
            const int npad = odd ? OD_PAD : EV_PAD;
            pg8::Gemm g{hbuf, w_in, T, npad, D}; pg8::InOrder S; S.init(npad, D, gridDim.x, blockIdx.x, 4, OU_O / 256, last ? (OU_O + 2048) / 256 : OU_O / 256);
            EpiU E{ubuf, ldu, (odd ? OD_MAIN : EV_MAIN) / 256, gates,
                   odd ? pin(p, I_MCONVW) + (size_t)e * 3 * 2048 : pin(p, I_SCONVW) + (size_t)e * 3 * 1536, odd ? pin(p, I_MCONVB) + (size_t)e * 2048 : pin(p, I_SCONVB) + (size_t)e * 1536,
                   odd ? 0 : EU_XBC / 256, odd ? 8 : (EU_XBC + 1536) / 256, odd ? 2048 : 1536, odd ? 4 : 1000, lds};
            pg8::gemm_phase<EpiU, pg8::InOrder, true, true>(wv, lds, g, S, E);
            SEAM(pb + 1);
        }
        if (IN(pb + 3)) {
            if (!odd) {
                phase_ssd_chunk(wv, ubuf, gates, pin(p, I_ALOG) + e * 32, pin(p, I_DTB) + e * 32, so, lds); __syncthreads();
                phase_hgrn_chunk(wv, ubuf, pin(p, I_HLB), e, so, lds);
            } else {
                phase_mlstm_chunk(wv, ubuf, gates, pin(p, I_MGATEB) + e * 16, so, lds);
            }
            SEAM(pb + 3);
        }
        if (IN(pb + 4)) {
            if (!odd) phase_out_even(wv, ubuf, so, pin(p, I_SSDD) + e * 16, pin(p, I_SSDNW) + e * 1024, pin(p, I_HNW) + e * 1024, hbuf, row_lo2);
            else phase_out_odd(wv, ubuf, so, pin(p, I_MNW) + (size_t)e * D, hbuf, row_lo2);
            SEAM(pb + 4);
        }
        if (IN(pb + 5)) {
            const int M = T - row_lo2;
            pg8::Gemm g{hbuf, w_out, M, D, D}; pg8::ResOrder S; S.init(D, D, gridDim.x, blockIdx.x, last ? 0 : 1, 4);
            EpiRes E{xc_cur, xc, xl_cur, xl, first ? 1 : 0, modl + 2 * D, 0, pbuf};
            pg8::gemm_phase<EpiRes, pg8::ResOrder, true, true>(wv, lds, g, S, E);
            SEAM(pb + 5);
        }
        if (IN(pb + 6)) { phase_norm(wv, xc, xl, false, pin(p, I_NORMW) + (size_t)(l * 2 + 1) * D, modl, 4, 3, hbuf, row_lo2, (last || !split_ok) ? (const float*)nullptr : pbuf, xc, lds); SEAM(pb + 6); }
        if (IN(pb + 7)) {
            const int M = T - row_lo2;
            pg8::Gemm g{hbuf + (size_t)row_lo2 * D, w1, M, DFF, D}; pg8::StaticOrder S; S.init(M, DFF, D, gridDim.x, blockIdx.x, 4);
            EpiAct E{ubuf + (size_t)row_lo2 * DFF, DFF};
            pg8::gemm_phase<EpiAct, pg8::StaticOrder, true, true>(wv, lds, g, S, E);
            SEAM(pb + 7);
        }
        if (IN(pb + 8)) {
            const int M = T - row_lo2;
            pg8::Gemm g{ubuf, w2, M, D, DFF}; pg8::ResOrder S; S.init(D, DFF, gridDim.x, blockIdx.x, last ? 0 : 1, 4);
            EpiRes E{xc, xc, xl, xl, 0, modl + 5 * D, 0, pbuf};
            pg8::gemm_phase<EpiRes, pg8::ResOrder, true, true>(wv, lds, g, S, E);
            SEAM(pb + 8);
        }
    }
#undef CONVERT_LAYER
    if (IN(NPH - 1)) phase_final_norm(wv, xl, p.out, pin(p, I_FNORMW));
#undef IN
#undef SEAM
}

extern "C" void kernel_launch(void* const* d_in, const int* in_sizes, int n_in, void* d_out, int out_size, void* d_ws, size_t ws_size, hipStream_t stream) {
    static int grid = 0;
    if (grid == 0) {
        if (n_in != 26 || out_size != TL * D || ws_size < WS_END) { fprintf(stderr, "kernel_launch: unexpected shapes (n_in %d out %d ws %zu need %zu)\n", n_in, out_size, ws_size, (size_t)WS_END); grid = -1; return; }
        int dev = 0, cus = 0;
        if (hipGetDevice(&dev) != hipSuccess || hipDeviceGetAttribute(&cus, hipDeviceAttributeMultiprocessorCount, dev) != hipSuccess) { grid = -1; return; }
        if (hipFuncSetAttribute((const void*)fwd_kernel, hipFuncAttributeMaxDynamicSharedMemorySize, LDS_BYTES) != hipSuccess) { fprintf(stderr, "kernel_launch: hipFuncSetAttribute failed\n"); grid = -1; return; }
        int per_cu = 0;
        if (hipOccupancyMaxActiveBlocksPerMultiprocessor(&per_cu, (const void*)fwd_kernel, 512, LDS_BYTES) != hipSuccess || per_cu < 1) { fprintf(stderr, "kernel_launch: occupancy query says %d\n", per_cu); }
        (void)hipGetLastError();
        grid = cus;
    }
    if (grid < 0) return;
    (void)hipMemsetAsync((char*)d_ws + WS_CTL, 0, CTL_BYTES, stream);
    Params p{};
    for (int i = 0; i < 26; ++i) p.in[i] = (const float*)d_in[i];
    p.out = (float*)d_out; p.ws = (unsigned char*)d_ws;
#if ONE_LAUNCH
    p.ph_lo = 0; p.ph_hi = NPH;
    hipLaunchKernelGGL(fwd_kernel, dim3(grid), dim3(512), LDS_BYTES, stream, p);
#else
    for (int k = 0; k < NPH; ++k) { p.ph_lo = k; p.ph_hi = k + 1; hipLaunchKernelGGL(fwd_kernel, dim3(grid), dim3(512), LDS_BYTES, stream, p); }
#endif
}
```
